# Optimizing an MI355X kernel written in HIP

```python
import math
import jax, jax.numpy as jnp
from jax import lax
import numpy as np

D_MODEL = 2048
BATCH = 4
SEQ = 4096
DEPTH = 1

N_MEM = 256
HEAD_DIM = 128
GDN_HEADS = 8
SB_HEADS = 4
MEM_HEADS = 4
GDN_WIDTH = GDN_HEADS * HEAD_DIM
SB_WIDTH = SB_HEADS * HEAD_DIM
MEM_WIDTH = MEM_HEADS * HEAD_DIM
MIX_WIDTH = GDN_WIDTH + SB_WIDTH + MEM_WIDTH
IN_COLS = 4 * GDN_WIDTH + 2 * GDN_HEADS + 3 * SB_WIDTH + MEM_WIDTH
CONV_WIDTH = 4
GDN_CHUNK = 64
SB_BLOCK = 128
PEER_HEADS = 8
PEER_N_KEYS = 128
PEER_N_EXPERTS = PEER_N_KEYS * PEER_N_KEYS
PEER_TOPK = 16
PEER_D_HALF = 128
PEER_D_QUERY = 2 * PEER_D_HALF
PEER_TOKEN_BLOCK = 128
DEEPNORM_ALPHA = (2 * DEPTH) ** 0.25
DEEPNORM_BETA = (8 * DEPTH) ** -0.25
LN_EPS = 1e-5
RMS_EPS = 1e-6

kernel_name = 'hybrid_gdn_stickbreak_mem_peer_deepnorm'


def layer_norm(x, w, b):
    xf = x.astype(jnp.float32)
    mu = jnp.mean(xf, axis=-1, keepdims=True)
    var = jnp.mean(jnp.square(xf - mu), axis=-1, keepdims=True)
    return ((xf - mu) * lax.rsqrt(var + LN_EPS) * w.astype(jnp.float32) + b.astype(jnp.float32)).astype(x.dtype)


def rms_norm(x, w):
    xf = x.astype(jnp.float32)
    return xf * lax.rsqrt(jnp.mean(jnp.square(xf), axis=-1, keepdims=True) + RMS_EPS) * w.astype(jnp.float32)


def l2_normalize(x):
    return x * lax.rsqrt(jnp.sum(jnp.square(x), axis=-1, keepdims=True) + RMS_EPS)


def causal_conv(x, w):
    T = x.shape[1]
    xp = jnp.pad(x, ((0, 0), (CONV_WIDTH - 1, 0), (0, 0)))
    return sum(xp[:, i:i + T] * w[i] for i in range(CONV_WIDTH))


def to_heads(t, n_heads):
    B, T, _ = t.shape
    return t.reshape(B, T, n_heads, HEAD_DIM).transpose(0, 2, 1, 3)


def gated_delta_rule_chunked(q, k, v, g, beta):
    f32 = jnp.float32
    q, k, v, g, beta = (t.astype(f32) for t in (q, k, v, g, beta))
    B, H, T, Dk = q.shape
    Dv = v.shape[-1]
    C = GDN_CHUNK
    N = T // C
    q = q.reshape(B, H, N, C, Dk)
    k = k.reshape(B, H, N, C, Dk)
    v = v.reshape(B, H, N, C, Dv)
    beta = beta.reshape(B, H, N, C)
    g = jnp.cumsum(g.reshape(B, H, N, C), axis=-1)
    k_beta = k * beta[..., None]
    v_beta = v * beta[..., None]
    tril = jnp.tril(jnp.ones((C, C), dtype=bool))
    strict = jnp.tril(jnp.ones((C, C), dtype=bool), -1)
    decay = jnp.exp(jnp.where(tril, g[..., :, None] - g[..., None, :], -jnp.inf))
    lower = jnp.where(strict, jnp.einsum('bhnid,bhnjd->bhnij', k_beta, k) * decay, 0.0)
    a_mat = lower + jnp.eye(C, dtype=f32)
    u = lax.linalg.triangular_solve(a_mat, v_beta, left_side=True, lower=True, unit_diagonal=True)
    w = lax.linalg.triangular_solve(a_mat, k_beta * jnp.exp(g)[..., None], left_side=True, lower=True, unit_diagonal=True)
    qk = jnp.einsum('bhnid,bhnjd->bhnij', q, k) * decay

    def step(S, inp):
        q_c, k_c, u_c, w_c, g_c, qk_c = inp
        v_new = u_c - jnp.einsum('bhcd,bhde->bhce', w_c, S)
        o = jnp.einsum('bhcd,bhde->bhce', q_c * jnp.exp(g_c)[..., None], S) + jnp.einsum('bhij,bhje->bhie', qk_c, v_new)
        g_last = g_c[..., -1]
        S = S * jnp.exp(g_last)[..., None, None] + jnp.einsum('bhcd,bhce->bhde', k_c * jnp.exp(g_last[..., None] - g_c)[..., None], v_new)
        return S, o

    xs = tuple(jnp.moveaxis(t, 2, 0) for t in (q, k, u, w, g, qk))
    S0 = jnp.zeros((B, H, Dk, Dv), f32)
    _, o = lax.scan(step, S0, xs)
    return jnp.moveaxis(o, 0, 2).reshape(B, H, T, Dv)


def stick_breaking_attention(q, k, v):
    T = q.shape[2]
    scale = HEAD_DIM ** -0.5
    outs = []
    for blk in range(T // SB_BLOCK):
        t0 = blk * SB_BLOCK
        t1 = t0 + SB_BLOCK
        qb = q[:, :, t0:t1]
        kb = k[:, :, :t1]
        vb = v[:, :, :t1]
        z = jnp.einsum('bhqd,bhkd->bhqk', qb, kb).astype(jnp.float32) * scale
        causal = jnp.arange(t1)[None, :] < (t0 + jnp.arange(SB_BLOCK))[:, None]
        log_not = jnp.where(causal, -jax.nn.softplus(z), 0.0)
        after = lax.cumsum(log_not, axis=3, reverse=True) - log_not
        a = jnp.where(causal, jnp.exp(jax.nn.log_sigmoid(z) + after), 0.0)
        outs.append(jnp.einsum('bhqk,bhkd->bhqd', a.astype(vb.dtype), vb))
    return jnp.concatenate(outs, axis=2)


def mixing_block(h, mem, w_in, conv_w, a_log, dt_bias, gdn_norm_w, sb_norm_w, mem_norm_w,
                 ln_mem_w, ln_mem_b, w_mem_kv, w_out):
    B, T, _ = h.shape
    f32 = jnp.float32
    proj = h @ w_in
    o1 = 3 * GDN_WIDTH
    o2 = o1 + GDN_WIDTH
    o3 = o2 + GDN_HEADS
    o4 = o3 + GDN_HEADS
    o5 = o4 + 3 * SB_WIDTH
    gdn_qkv, gdn_z, gdn_a, gdn_b, sb_qkv, mem_q = jnp.split(proj, [o1, o2, o3, o4, o5], axis=-1)

    qkv = jax.nn.silu(causal_conv(gdn_qkv, conv_w))
    q, k, v = (to_heads(t, GDN_HEADS) for t in jnp.split(qkv, 3, axis=-1))
    q = l2_normalize(q.astype(f32)) * HEAD_DIM ** -0.5
    k = l2_normalize(k.astype(f32))
    g = -jnp.exp(a_log.astype(f32)) * jax.nn.softplus(gdn_a.astype(f32) + dt_bias.astype(f32))
    beta = jax.nn.sigmoid(gdn_b.astype(f32))
    o_gdn = gated_delta_rule_chunked(q, k, v, g.transpose(0, 2, 1), beta.transpose(0, 2, 1))
    o_gdn = o_gdn.transpose(0, 2, 1, 3)
    z = gdn_z.reshape(B, T, GDN_HEADS, HEAD_DIM).astype(f32)
    o_gdn = (rms_norm(o_gdn, gdn_norm_w) * jax.nn.silu(z)).reshape(B, T, GDN_WIDTH)

    q_sb, k_sb, v_sb = (to_heads(t, SB_HEADS) for t in jnp.split(sb_qkv, 3, axis=-1))
    o_sb = stick_breaking_attention(q_sb, k_sb, v_sb).transpose(0, 2, 1, 3)
    o_sb = rms_norm(o_sb, sb_norm_w.reshape(SB_HEADS, HEAD_DIM)).reshape(B, T, SB_WIDTH)

    m = layer_norm(mem, ln_mem_w, ln_mem_b)
    mk, mv = jnp.split(m @ w_mem_kv, 2, axis=-1)
    mk = mk.reshape(B, N_MEM, MEM_HEADS, HEAD_DIM)
    mv = mv.reshape(B, N_MEM, MEM_HEADS, HEAD_DIM)
    qm = mem_q.reshape(B, T, MEM_HEADS, HEAD_DIM)
    s = jnp.einsum('bthd,bmhd->bhtm', qm, mk).astype(f32) * HEAD_DIM ** -0.5
    p = jax.nn.softmax(s, axis=-1)
    o_mem = jnp.einsum('bhtm,bmhd->bthd', p.astype(mv.dtype), mv)
    o_mem = rms_norm(o_mem, mem_norm_w.reshape(MEM_HEADS, HEAD_DIM)).reshape(B, T, MEM_WIDTH)

    o = jnp.concatenate([o_gdn, o_sb, o_mem], axis=-1).astype(h.dtype)
    return o @ w_out


def peer_ffn(h, wq, keys1, keys2, u, v):
    B, T, D = h.shape
    TB = PEER_TOKEN_BLOCK
    nb = (B * T) // TB
    xt = h.reshape(B * T, D)
    q = (xt @ wq).reshape(B * T, PEER_HEADS, 2, PEER_D_HALF)
    s1 = jnp.einsum('thd,kd->thk', q[:, :, 0], keys1).astype(jnp.float32)
    s2 = jnp.einsum('thd,kd->thk', q[:, :, 1], keys2).astype(jnp.float32)
    v1, i1 = lax.top_k(s1, PEER_TOPK)
    v2, i2 = lax.top_k(s2, PEER_TOPK)
    cand_s = (v1[..., :, None] + v2[..., None, :]).reshape(B * T, PEER_HEADS, PEER_TOPK * PEER_TOPK)
    cand_i = (i1[..., :, None] * PEER_N_KEYS + i2[..., None, :]).reshape(B * T, PEER_HEADS, PEER_TOPK * PEER_TOPK)
    top_s, pos = lax.top_k(cand_s, PEER_TOPK)
    idx = jnp.take_along_axis(cand_i, pos, axis=-1)
    gate = jax.nn.softmax(top_s, axis=-1)

    def expert_block(args):
        xb, ib, gb = args
        ub = jnp.take(u, ib, axis=0)
        act = jax.nn.gelu(jnp.einsum('td,thkd->thk', xb, ub).astype(jnp.float32), approximate=False)
        wgt = (gb * act).astype(v.dtype)
        return jnp.einsum('thk,thkd->td', wgt, jnp.take(v, ib, axis=0))

    out = lax.map(expert_block, (xt.reshape(nb, TB, D),
                                 idx.reshape(nb, TB, PEER_HEADS, PEER_TOPK),
                                 gate.reshape(nb, TB, PEER_HEADS, PEER_TOPK)))
    return out.reshape(B, T, D).astype(h.dtype)


def setup_inputs(seed: int = 0) -> dict:
    key = jax.random.key(seed)
    ks = jax.random.split(key, 32)
    f32 = jnp.float32
    L = DEPTH

    def nrm(k, shape, scale):
        return jax.random.normal(k, shape, f32) * scale

    def gain(k, shape):
        return 1.0 + 0.02 * jax.random.normal(k, shape, f32)

    def bias(k, shape):
        return 0.02 * jax.random.normal(k, shape, f32)

    dt = jnp.exp(jax.random.uniform(ks[6], (L, GDN_HEADS), f32, math.log(1e-3), math.log(1e-1)))
    return {
        'x': nrm(ks[0], (BATCH, SEQ, D_MODEL), 1.0),
        'mem': nrm(ks[1], (BATCH, N_MEM, D_MODEL), 1.0),
        'ln_emb_w': gain(ks[2], (D_MODEL,)),
        'ln_emb_b': bias(ks[3], (D_MODEL,)),
        'w_in': nrm(ks[4], (L, D_MODEL, IN_COLS), D_MODEL ** -0.5),
        'conv_w': nrm(ks[5], (L, CONV_WIDTH, 3 * GDN_WIDTH), CONV_WIDTH ** -0.5),
        'a_log': jnp.log(jax.random.uniform(ks[7], (L, GDN_HEADS), f32, 1.0, 16.0)),
        'dt_bias': dt + jnp.log(-jnp.expm1(-dt)),
        'gdn_norm_w': gain(ks[8], (L, HEAD_DIM)),
        'sb_norm_w': gain(ks[9], (L, SB_WIDTH)),
        'mem_norm_w': gain(ks[10], (L, MEM_WIDTH)),
        'ln_mem_w': gain(ks[11], (L, D_MODEL)),
        'ln_mem_b': bias(ks[12], (L, D_MODEL)),
        'w_mem_kv': nrm(ks[13], (L, D_MODEL, 2 * MEM_WIDTH), D_MODEL ** -0.5),
        'w_out': nrm(ks[14], (L, MIX_WIDTH, D_MODEL), MIX_WIDTH ** -0.5 * DEEPNORM_BETA),
        'ln1_w': gain(ks[15], (L, D_MODEL)),
        'ln1_b': bias(ks[16], (L, D_MODEL)),
        'peer_wq': nrm(ks[17], (L, D_MODEL, PEER_HEADS * PEER_D_QUERY), D_MODEL ** -0.5),
        'peer_keys1': nrm(ks[18], (L, PEER_N_KEYS, PEER_D_HALF), PEER_D_HALF ** -0.5),
        'peer_keys2': nrm(ks[19], (L, PEER_N_KEYS, PEER_D_HALF), PEER_D_HALF ** -0.5),
        'peer_u': nrm(ks[20], (L, PEER_N_EXPERTS, D_MODEL), D_MODEL ** -0.5),
        'peer_v': nrm(ks[21], (L, PEER_N_EXPERTS, D_MODEL), DEEPNORM_BETA),
        'ln2_w': gain(ks[22], (L, D_MODEL)),
        'ln2_b': bias(ks[23], (L, D_MODEL)),
    }


def reference(x, mem, ln_emb_w, ln_emb_b, w_in, conv_w, a_log, dt_bias, gdn_norm_w, sb_norm_w,
              mem_norm_w, ln_mem_w, ln_mem_b, w_mem_kv, w_out, ln1_w, ln1_b, peer_wq, peer_keys1,
              peer_keys2, peer_u, peer_v, ln2_w, ln2_b):
    h = layer_norm(x, ln_emb_w, ln_emb_b)
    for l in range(DEPTH):
        mix = mixing_block(h, mem, w_in[l], conv_w[l], a_log[l], dt_bias[l], gdn_norm_w[l], sb_norm_w[l],
                           mem_norm_w[l], ln_mem_w[l], ln_mem_b[l], w_mem_kv[l], w_out[l])
        h = layer_norm(DEEPNORM_ALPHA * h + mix, ln1_w[l], ln1_b[l])
        ffn = peer_ffn(h, peer_wq[l], peer_keys1[l], peer_keys2[l], peer_u[l], peer_v[l])
        h = layer_norm(DEEPNORM_ALPHA * h + ffn, ln2_w[l], ln2_b[l])
    return h
```

```cpp
#include <hip/hip_runtime.h>
#include <hip/hip_cooperative_groups.h>
#include <cstdio>
#include <cstdint>
#include <cmath>
namespace cg = cooperative_groups;

namespace pg8 {
#define PG8_LAS __attribute__((address_space(3)))
typedef unsigned short bf16_t;
typedef short bf16x8 __attribute__((ext_vector_type(8)));
typedef float f32x4 __attribute__((ext_vector_type(4)));
typedef unsigned u32x4 __attribute__((ext_vector_type(4)));
constexpr int BM = 256, BK = 64, HALF = 128, HTB = HALF * BK * 2  , STAGE_BYTES = 8 * HTB, NXCD = 8, WGM = 8;

__host__ __device__ __forceinline__ int lds_byte(int r, int c) { const int st = (r >> 4) * 2 + (c >> 5), rr = r & 15, cc = c & 31, ob = rr * 64 + cc * 2; return st * 1024 + (ob ^ (((ob >> 9) & 1) << 5)); }
__host__ __device__ __forceinline__ void stage_rc(int b, int& R, int& C) { const int st = b / 1024, sb = b % 1024, swz = sb ^ (((sb >> 9) & 1) << 5); R = (st >> 1) * 16 + swz / 64; C = (st & 1) * 32 + (swz % 64) / 2; }
__host__ __device__ __forceinline__ int perm32(int rho) { const int n = rho >> 4, i = rho & 15; return 8 * (i >> 2) + 4 * n + (i & 3); }

struct Unit { int pm, pn; };
struct Gemm { const bf16_t* A; const bf16_t* Bt; int M, N, K; };

struct StaticOrder {
    int nM, nN, nwg, G, c;
    __host__ __device__ void init(int M, int N, int G_, int c_) { nM = M / BM; nN = N / BM; nwg = nM * nN; G = G_; c = c_; }
    __host__ __device__ bool next(int i, Unit& u) const {
        const long L = (long)i * G + c; if (L >= nwg) return false;
        int wgid = (int)L; { const int q = nwg / NXCD, r = nwg % NXCD, xcd = wgid % NXCD, off = wgid / NXCD; wgid = (xcd < r ? xcd * (q + 1) : r * (q + 1) + (xcd - r) * q) + off; }
        const int nig = WGM * nN, gid = wgid / nig, fm = gid * WGM, gsz = (nM - fm) < WGM ? (nM - fm) : WGM;
        u.pm = fm + ((wgid % nig) % gsz); u.pn = (wgid % nig) / gsz; return true;
    }
    __device__ __forceinline__ void a_ready(const Unit&) const {}
    __device__ __forceinline__ void done(const Unit&) const {}
};

__device__ __forceinline__ unsigned cvt_pk_bf16(float lo, float hi) { unsigned r; asm volatile("v_cvt_pk_bf16_f32 %0, %1, %2" : "=v"(r) : "v"(lo), "v"(hi)); return r; }
typedef float f32x2 __attribute__((ext_vector_type(2)));
__device__ __forceinline__ f32x2 gelu_pk(f32x2 v) {
    const f32x2 av = __builtin_elementwise_abs(v), d = av * 0.2316418882f + 1.0f;
    f32x2 t; t.x = __builtin_amdgcn_rcpf(d.x); t.y = __builtin_amdgcn_rcpf(d.y);
    f32x2 q = t * 0.5307027145f + (-0.7265760135f); q = q * t + 0.7107068705f; q = q * t + (-0.142248368f); q = q * t + 0.127414796f; q = q * t;
    const f32x2 s = (v * v) * (-0.72134752044f);
    f32x2 e; e.x = __builtin_amdgcn_exp2f(s.x); e.y = __builtin_amdgcn_exp2f(s.y);
    const f32x2 m = v * (q * e), r = v - m;
    f32x2 o; o.x = v.x < 0.f ? m.x : r.x; o.y = v.y < 0.f ? m.y : r.y; return o;
}

template <int ACT  > struct EpiBf16 {
    static constexpr bool PERM = true, AFTER_DRAIN = false; static_assert(ACT == 0 || ACT == 1, "EpiBf16: ACT is 0 (none) or 1 (gelu_pk)");
    bf16_t* O; int ldc; const float* bias; int split_cols; size_t split_stride; float scale0;
    __device__ __forceinline__ void operator()(const f32x4 (&acc)[2][2][4][2], const Unit& u, int wr, int wc, int fr, int fq) const {
        const int row0 = u.pm * BM + wr * 64 + fr; int colt = u.pn * BM; bf16_t* base = O;
        float sc = 1.f; if (split_cols) { const int t = colt / split_cols; base += (size_t)t * split_stride; colt -= t * split_cols; if (t == 0) sc = scale0; }
        const int col0 = colt + wc * 32 + 8 * fq, bcol0 = u.pn * BM + wc * 32 + 8 * fq;
        f32x4 bv[2][2];
#pragma unroll
        for (int bj = 0; bj < 2; ++bj)
#pragma unroll
            for (int n = 0; n < 2; ++n) bv[bj][n] = bias ? *(const f32x4*)(bias + bcol0 + bj * HALF + 4 * n) : (f32x4){0.f, 0.f, 0.f, 0.f};
#pragma unroll
        for (int ai = 0; ai < 2; ++ai)
#pragma unroll
            for (int m = 0; m < 4; ++m) { bf16_t* rowp = base + (size_t)(row0 + ai * HALF + m * 16) * ldc + col0;
#pragma unroll
                for (int bj = 0; bj < 2; ++bj) { f32x4 v0 = acc[ai][bj][m][0] + bv[bj][0], v1 = acc[ai][bj][m][1] + bv[bj][1];
                    if (ACT == 1) { f32x2 a = gelu_pk((f32x2){v0[0], v0[1]}), b = gelu_pk((f32x2){v0[2], v0[3]}), c = gelu_pk((f32x2){v1[0], v1[1]}), d = gelu_pk((f32x2){v1[2], v1[3]});
                        v0 = (f32x4){a.x, a.y, b.x, b.y}; v1 = (f32x4){c.x, c.y, d.x, d.y}; }
                    v0 = v0 * sc; v1 = v1 * sc; u32x4 w; w.x = cvt_pk_bf16(v0[0], v0[1]); w.y = cvt_pk_bf16(v0[2], v0[3]); w.z = cvt_pk_bf16(v1[0], v1[1]); w.w = cvt_pk_bf16(v1[2], v1[3]);
                    *(u32x4*)(rowp + bj * HALF) = w; } }
    }
};

template <class Epi, class Sched, bool ALIGN_EPI = false, bool SP2 = false>
__device__ __forceinline__ void gemm_phase(PG8_LAS unsigned char* lds, const Gemm g, const Sched& S, const Epi& E, const int wid, const int lane) {
    const int tid = wid * 64 + lane, wr = wid >> 2, wc = wid & 3, fr = lane & 15, fq = lane >> 4;
    const int K = g.K, nt = K / BK;
    unsigned voffA[2], voffB[2];
#pragma unroll
    for (int i = 0; i < 2; ++i) { int R, C; stage_rc(tid * 16 + i * 8192, R, C); const int Rb = Epi::PERM ? ((R & ~31) + perm32(R & 31)) : R;
        voffA[i] = (unsigned)(R * K + C) * 2u; voffB[i] = (unsigned)(Rb * K + C) * 2u; }
    const size_t kstep = (size_t)(BK * 2);
    const size_t hstep = (size_t)HALF * K * 2;
    const size_t tstep = 2 * hstep;
    const unsigned ldsw = (unsigned)wid * 1024u;
    const int aoff = lds_byte(wr * 64 + fr, fq * 8), boff = lds_byte(wc * 32 + fr, fq * 8);
#define PG8_SA(b, h) (((b) * 2 + (h)) * HTB)
#define PG8_SB(b, h) ((4 + (b) * 2 + (h)) * HTB)
#define PG8_STAGE(bufoff, gbase, voff) do { _Pragma("unroll") for (int _i = 0; _i < 2; ++_i) \
        __builtin_amdgcn_global_load_lds((const unsigned*)((const char*)(gbase) + (voff)[_i]), (PG8_LAS unsigned*)(lds + (bufoff) + ldsw + _i * 8192), 16, 0, 0); } while (0)
#define PG8_LDA(dst, b, h) do { _Pragma("unroll") for (int m = 0; m < 4; ++m) _Pragma("unroll") for (int k = 0; k < 2; ++k) dst[m][k] = *(const PG8_LAS bf16x8*)(lds + PG8_SA(b, h) + aoff + m * 2048 + k * 1024); } while (0)
#define PG8_LDB(dst, b, h) do { _Pragma("unroll") for (int n = 0; n < 2; ++n) _Pragma("unroll") for (int k = 0; k < 2; ++k) dst[n][k] = *(const PG8_LAS bf16x8*)(lds + PG8_SB(b, h) + boff + n * 2048 + k * 1024); } while (0)
#define PG8_MMA(ai, bj, At, Bt) do { __builtin_amdgcn_s_setprio(1); _Pragma("unroll") for (int m = 0; m < 4; ++m) _Pragma("unroll") for (int n = 0; n < 2; ++n) _Pragma("unroll") for (int k = 0; k < 2; ++k) \
        acc[ai][bj][m][n] = __builtin_amdgcn_mfma_f32_16x16x32_bf16(Bt[n][k], At[m][k], acc[ai][bj][m][n], 0, 0, 0); __builtin_amdgcn_s_setprio(0); } while (0)
#define PG8_WAIT_V(n) asm volatile("s_waitcnt vmcnt(" #n ")" ::: "memory")
#define PG8_WAIT_L(n) asm volatile("s_waitcnt lgkmcnt(" #n ")" ::: "memory")
#define PG8_BAR __builtin_amdgcn_s_barrier()
#define PG8_SCHED __builtin_amdgcn_sched_barrier(0)
    Unit cur, nxt; int ui = 0;
    if (!S.next(0, cur)) return;
    f32x4 acc[2][2][4][2];
#pragma unroll
    for (int a = 0; a < 2; ++a)
#pragma unroll
        for (int b = 0; b < 2; ++b)
#pragma unroll
            for (int m = 0; m < 4; ++m)
#pragma unroll
                for (int n = 0; n < 2; ++n) acc[a][b][m][n] = (f32x4){0.f, 0.f, 0.f, 0.f};
    bf16x8 At[4][2], B0[2][2], B1[2][2];
    const char* cA = (const char*)g.A + (size_t)cur.pm * tstep; const char* cB = (const char*)g.Bt + (size_t)cur.pn * tstep;
    S.a_ready(cur);
    if constexpr (SP2) {
        PG8_STAGE(PG8_SB(0, 0), cB, voffB); PG8_STAGE(PG8_SB(0, 1), cB + hstep, voffB); PG8_STAGE(PG8_SA(0, 0), cA, voffA); PG8_STAGE(PG8_SA(0, 1), cA + hstep, voffA);
        if (wr == 1) PG8_BAR;
        PG8_WAIT_V(2); PG8_BAR;
        PG8_STAGE(PG8_SB(1, 0), cB + kstep, voffB); PG8_STAGE(PG8_SA(1, 0), cA + kstep, voffA); PG8_STAGE(PG8_SB(1, 1), cB + hstep + kstep, voffB);
        PG8_WAIT_V(6); PG8_BAR;
    } else {
        PG8_STAGE(PG8_SB(0, 0), cB, voffB); PG8_STAGE(PG8_SA(0, 0), cA, voffA); PG8_STAGE(PG8_SB(0, 1), cB + hstep, voffB); PG8_STAGE(PG8_SA(0, 1), cA + hstep, voffA);
        if (wr == 1) PG8_BAR;
        PG8_WAIT_V(4); PG8_BAR;
        PG8_STAGE(PG8_SB(1, 0), cB + kstep, voffB); PG8_STAGE(PG8_SA(1, 0), cA + kstep, voffA); PG8_STAGE(PG8_SB(1, 1), cB + hstep + kstep, voffB);
        PG8_WAIT_V(6); PG8_BAR;
    }
    for (;;) {
        const bool has_next = S.next(ui + 1, nxt);
        const char* nA = has_next ? (const char*)g.A + (size_t)nxt.pm * tstep : cA; const char* nB = has_next ? (const char*)g.Bt + (size_t)nxt.pn * tstep : cB;
        for (int t = 0; t < nt; t += 2) {
            const bool last = (t == nt - 2);
            const char* a1 = cA + (size_t)(t + 1) * kstep;
            const char* a2 = last ? nA : cA + (size_t)(t + 2) * kstep; const char* b2 = last ? nB : cB + (size_t)(t + 2) * kstep;
            const char* a3 = a2 + kstep; const char* b3 = b2 + kstep;
            if (last && has_next) S.a_ready(nxt);
            if constexpr (SP2) {
            PG8_LDB(B0, 0, 0); PG8_LDB(B1, 0, 1); PG8_SCHED; PG8_LDA(At, 0, 0); PG8_STAGE(PG8_SA(1, 1), a1 + hstep, voffA);
            PG8_WAIT_V(8); PG8_WAIT_L(0); PG8_BAR; PG8_MMA(0, 0, At, B0); PG8_MMA(0, 1, At, B1); PG8_BAR; PG8_SCHED;
            PG8_LDA(At, 0, 1); PG8_STAGE(PG8_SB(0, 0), b2, voffB); PG8_STAGE(PG8_SB(0, 1), b2 + hstep, voffB); PG8_STAGE(PG8_SA(0, 0), a2, voffA);
            PG8_WAIT_V(8); PG8_WAIT_L(0); PG8_BAR; PG8_MMA(1, 0, At, B0); PG8_MMA(1, 1, At, B1); PG8_BAR; PG8_SCHED;
            PG8_LDB(B0, 1, 0); PG8_LDB(B1, 1, 1); PG8_SCHED; PG8_LDA(At, 1, 0); PG8_STAGE(PG8_SA(0, 1), a2 + hstep, voffA);
            PG8_WAIT_V(8); PG8_WAIT_L(0); PG8_BAR; PG8_MMA(0, 0, At, B0); PG8_MMA(0, 1, At, B1); PG8_BAR; PG8_SCHED;
            PG8_LDA(At, 1, 1); PG8_STAGE(PG8_SB(1, 0), b3, voffB); PG8_STAGE(PG8_SB(1, 1), b3 + hstep, voffB); PG8_STAGE(PG8_SA(1, 0), a3, voffA);
            PG8_WAIT_V(8); PG8_WAIT_L(0); PG8_BAR; PG8_MMA(1, 0, At, B0); PG8_MMA(1, 1, At, B1); PG8_BAR; PG8_SCHED;
            } else {
            PG8_LDB(B0, 0, 0); PG8_SCHED; PG8_LDA(At, 0, 0); PG8_STAGE(PG8_SA(1, 1), a1 + hstep, voffA);
            PG8_WAIT_L(8); PG8_BAR; PG8_WAIT_L(0); PG8_MMA(0, 0, At, B0); PG8_BAR; PG8_SCHED;
            PG8_LDB(B1, 0, 1); PG8_STAGE(PG8_SB(0, 0), b2, voffB);
            PG8_BAR; PG8_WAIT_L(0); PG8_MMA(0, 1, At, B1); PG8_BAR;
            PG8_LDA(At, 0, 1); PG8_STAGE(PG8_SA(0, 0), a2, voffA);
            PG8_BAR; PG8_WAIT_L(0); PG8_MMA(1, 0, At, B0); PG8_BAR; PG8_SCHED;
            PG8_STAGE(PG8_SB(0, 1), b2 + hstep, voffB);
            PG8_WAIT_V(6); PG8_BAR; PG8_MMA(1, 1, At, B1); PG8_BAR;
            PG8_LDB(B0, 1, 0); PG8_SCHED; PG8_LDA(At, 1, 0); PG8_STAGE(PG8_SA(0, 1), a2 + hstep, voffA);
            PG8_WAIT_L(8); PG8_BAR; PG8_WAIT_L(0); PG8_MMA(0, 0, At, B0); PG8_BAR; PG8_SCHED;
            PG8_LDB(B1, 1, 1); PG8_STAGE(PG8_SB(1, 0), b3, voffB);
            PG8_BAR; PG8_WAIT_L(0); PG8_MMA(0, 1, At, B1); PG8_BAR;
            PG8_LDA(At, 1, 1); PG8_STAGE(PG8_SA(1, 0), a3, voffA);
            PG8_BAR; PG8_WAIT_L(0); PG8_MMA(1, 0, At, B0); PG8_BAR; PG8_SCHED;
            PG8_STAGE(PG8_SB(1, 1), b3 + hstep, voffB);
            PG8_WAIT_V(6); PG8_BAR; PG8_MMA(1, 1, At, B1); PG8_BAR;
            }
        }
        if constexpr (ALIGN_EPI) { if (wr == 0) PG8_BAR; }
        if constexpr (!Epi::AFTER_DRAIN) { E(acc, cur, wr, wc, fr, fq); S.done(cur); }
        if (!has_next) break;
#pragma unroll
        for (int a = 0; a < 2; ++a)
#pragma unroll
            for (int b = 0; b < 2; ++b)
#pragma unroll
                for (int m = 0; m < 4; ++m)
#pragma unroll
                    for (int n = 0; n < 2; ++n) acc[a][b][m][n] = (f32x4){0.f, 0.f, 0.f, 0.f};
        cur = nxt; cA = nA; cB = nB; ++ui;
        if constexpr (ALIGN_EPI) { if (wr == 1) PG8_BAR; }
    }
    PG8_WAIT_V(0);
    if constexpr (!ALIGN_EPI) { if (wr == 0) PG8_BAR; }
    PG8_BAR;
    if constexpr (Epi::AFTER_DRAIN) { E.fused(acc, cur, wr, wc, fr, fq, lds, wid, lane); S.done(cur); }
#undef PG8_SA
#undef PG8_SB
#undef PG8_STAGE
#undef PG8_LDA
#undef PG8_LDB
#undef PG8_MMA
#undef PG8_WAIT_V
#undef PG8_WAIT_L
#undef PG8_BAR
#undef PG8_SCHED
}
}

#ifndef MK_N_LAUNCHES
#define MK_N_LAUNCHES 1
#endif
constexpr int NWAVES = 8, NTHREADS = 512;
constexpr int BATCH = 4, SEQ = 4096, M = BATCH * SEQ, D = 2048, NMEM = 256, HD = 128;
constexpr int GH = 8, SBH = 4, MEMH = 4;
constexpr int IN_COLS = 6160, N1 = 6400, NKV = 1024;
constexpr int PROJ_LD = 6144, QKV_LD = 3072;
constexpr int PE_HEADS = 8, PE_KEYS = 128, PE_TOPK = 16, PE_NEXP = 16384, PE_SEL = PE_HEADS * PE_TOPK;
constexpr float ALPHA = 1.189207115002721f;
constexpr float LN_EPS = 1e-5f, RMS_EPS = 1e-6f;
constexpr int NPHASES = 9;

constexpr size_t MiB = 1u << 20;
constexpr size_t WS_CTL = 0, CTL_ZERO_BYTES = 65536;
constexpr size_t WS_W1T = 1 * MiB;
constexpr size_t WS_IDX = 1 * MiB, WS_GATE = 9 * MiB;
constexpr size_t WS_WOT = 30 * MiB;
constexpr size_t WS_WQT = 38 * MiB;
constexpr size_t WS_AB = 46 * MiB;
constexpr size_t WS_MKV = 47 * MiB;
constexpr size_t WS_XN = 49 * MiB;
constexpr size_t WS_PROJ = 117 * MiB;
constexpr size_t WS_Y1 = 117 * MiB;
constexpr size_t WS_OMIX = 309 * MiB;
constexpr size_t WS_Q = 309 * MiB;
constexpr size_t WS_QKVN = 373 * MiB;
constexpr size_t WS_UT = 373 * MiB, WS_VT = 405 * MiB;
constexpr size_t WS_G = 469 * MiB, WS_BETA = 469 * MiB + 512 * 1024;
constexpr size_t WS_QKF = 1 * MiB, WS_GL = 17 * MiB;
constexpr size_t WS_USTEP = 438 * MiB, WS_VSTEP = 437 * MiB;
constexpr size_t WS_PART = 181 * MiB;
constexpr size_t WS_XQ = 245 * MiB, WS_XSTEP = 277 * MiB;
constexpr size_t UT_SLICE = (size_t)16384 * 128, US_OFF = 16 * MiB, US_SLICE = (size_t)16384 * 16;
constexpr size_t WS_SMW = 20 * MiB;
constexpr int CW_KVFLAG = 9200;
constexpr size_t WS_END = 501 * MiB;

typedef unsigned short bf16;
#define GAS __attribute__((address_space(1)))
#define LAS __attribute__((address_space(3)))
typedef unsigned v4u __attribute__((ext_vector_type(4)));
typedef unsigned v2u __attribute__((ext_vector_type(2)));
typedef float f32x4 __attribute__((ext_vector_type(4)));

constexpr int LDS_BYTES = 163840;

typedef float f32x2_t __attribute__((ext_vector_type(2)));
typedef __bf16 bf16x2_t __attribute__((ext_vector_type(2)));
__device__ __forceinline__ unsigned cvtpk(float lo, float hi) { f32x2_t v = {lo, hi}; bf16x2_t b = __builtin_convertvector(v, bf16x2_t); return __builtin_bit_cast(unsigned, b); }
__device__ __forceinline__ unsigned f2bf(float f) { return cvtpk(f, f) & 0xffffu; }
__device__ __forceinline__ unsigned pk2(float lo, float hi) { return cvtpk(lo, hi); }
__device__ __forceinline__ float bflo(unsigned u) { return __builtin_bit_cast(float, u << 16); }
__device__ __forceinline__ float bfhi(unsigned u) { return __builtin_bit_cast(float, u & 0xffff0000u); }
__device__ __forceinline__ float bf2f(bf16 h) { return __builtin_bit_cast(float, (unsigned)h << 16); }
__device__ __forceinline__ float wave_sum(float v) {
#pragma unroll
    for (int o = 1; o < 64; o <<= 1) v += __shfl_xor(v, o);
    return v;
}
__device__ __forceinline__ float wave_max(float v) {
#pragma unroll
    for (int o = 1; o < 64; o <<= 1) v = fmaxf(v, __shfl_xor(v, o));
    return v;
}
__device__ __forceinline__ float softplus_f(float x) { return x > 20.f ? x : log1pf(__expf(x)); }
__device__ __forceinline__ float sigmoid_f(float x) { return __builtin_amdgcn_rcpf(1.f + __expf(-x)); }
__device__ __forceinline__ float silu_f(float x) { return x * __builtin_amdgcn_rcpf(1.f + __expf(-x)); }

struct Args { const float* in[24]; float* out; unsigned char* ws; int ph_lo, ph_hi; };

__device__ __forceinline__ const float* kin(int k) {
    const __attribute__((address_space(4))) unsigned long long* kp = (const __attribute__((address_space(4))) unsigned long long*)__builtin_amdgcn_kernarg_segment_ptr();
    return (const float*)kp[k];
}
__device__ __forceinline__ int fresh_lane() { unsigned z = 0u; asm volatile("" : "+v"(z)); return (int)__builtin_amdgcn_mbcnt_hi(~0u, __builtin_amdgcn_mbcnt_lo(~0u, z)); }
struct Frame {
    LAS unsigned char* lds;
    int wave, vcu, G;
    float* out; unsigned char* ws;
};

__device__ __forceinline__ int w1_dest_row(int n) { return n < 4096 ? n : (n < 4112 ? 6144 + (n - 4096) : n - 16); }
template <bool PERMUTE>
__device__ __forceinline__ void transpose_item(const float* W, int K, int N, bf16* WT, int row_off, LAS float* scr, int item, int lane) {
    const int nblk = (N + 31) / 32, kb = item / nblk, nb = item % nblk, k0 = 64 * kb, n0 = 32 * nb;
    const int ncol = n0 + (lane & 31);
    float tv[32];
#pragma unroll
    for (int i = 0; i < 32; ++i) { const int kk = 2 * i + (lane >> 5); tv[i] = (ncol < N) ? W[(size_t)(k0 + kk) * N + ncol] : 0.f; }
#pragma unroll
    for (int i = 0; i < 32; ++i) { const int kk = 2 * i + (lane >> 5); scr[kk * 33 + (lane & 31)] = tv[i]; }
    asm volatile("s_waitcnt lgkmcnt(0)" ::: "memory");
    const int c = lane & 7;
#pragma unroll
    for (int j = 0; j < 4; ++j) { const int n = (lane >> 3) + 8 * j; const LAS float* s = scr + (8 * c) * 33 + n;
        v4u o; o.x = pk2(s[0 * 33], s[1 * 33]); o.y = pk2(s[2 * 33], s[3 * 33]); o.z = pk2(s[4 * 33], s[5 * 33]); o.w = pk2(s[6 * 33], s[7 * 33]);
        const int ng = n0 + n;
        if (ng < N) { const int dr = PERMUTE ? w1_dest_row(ng) : ng; *(v4u*)(WT + (size_t)(row_off + dr) * K + k0 + 8 * c) = o; } }
    asm volatile("s_waitcnt lgkmcnt(0)" ::: "memory");
}
__device__ __forceinline__ void ln_row_bf16(const float* xrow, const float* w, const float* b, bf16* orow, int lane) {
    const f32x4* xr = (const f32x4*)xrow + lane;
    f32x4 v[8]; float s = 0.f;
#pragma unroll
    for (int j = 0; j < 8; ++j) { v[j] = xr[64 * j]; s += (v[j].x + v[j].y) + (v[j].z + v[j].w); }
    const float mean = wave_sum(s) * (1.f / D); float s2 = 0.f;
#pragma unroll
    for (int j = 0; j < 8; ++j) { v[j] = v[j] - mean; s2 += (v[j].x * v[j].x + v[j].y * v[j].y) + (v[j].z * v[j].z + v[j].w * v[j].w); }
    const float rstd = 1.f / sqrtf(wave_sum(s2) * (1.f / D) + LN_EPS);
    v2u* o8 = (v2u*)orow + lane;
#pragma unroll
    for (int j = 0; j < 8; ++j) { const f32x4 ww = ((const f32x4*)w)[lane + 64 * j], bb = ((const f32x4*)b)[lane + 64 * j];
        v2u o; o.x = pk2(v[j].x * rstd * ww.x + bb.x, v[j].y * rstd * ww.y + bb.y); o.y = pk2(v[j].z * rstd * ww.z + bb.z, v[j].w * rstd * ww.w + bb.w); o8[64 * j] = o; }
}
__device__ __forceinline__ void ln_rows2_bf16(const float* xa, const float* xb, const float* w, const float* b, bf16* oa, bf16* ob, const LAS unsigned char* wab, float* aba, float* abb, int lane) {
    const f32x4* pa = (const f32x4*)xa + lane; const f32x4* pb = (const f32x4*)xb + lane;
    f32x4 va[8], vb[8];
#pragma unroll
    for (int j = 0; j < 8; ++j) { va[j] = pa[64 * j]; vb[j] = pb[64 * j]; }
    float sa = 0.f, sb = 0.f;
#pragma unroll
    for (int j = 0; j < 8; ++j) { sa += (va[j].x + va[j].y) + (va[j].z + va[j].w); sb += (vb[j].x + vb[j].y) + (vb[j].z + vb[j].w); }
#pragma unroll
    for (int o = 1; o < 64; o <<= 1) { sa += __shfl_xor(sa, o); sb += __shfl_xor(sb, o); }
    const float ma = sa * (1.f / D), mb = sb * (1.f / D); float qa = 0.f, qb = 0.f;
#pragma unroll
    for (int j = 0; j < 8; ++j) { va[j] = va[j] - ma; vb[j] = vb[j] - mb;
        qa += (va[j].x * va[j].x + va[j].y * va[j].y) + (va[j].z * va[j].z + va[j].w * va[j].w); qb += (vb[j].x * vb[j].x + vb[j].y * vb[j].y) + (vb[j].z * vb[j].z + vb[j].w * vb[j].w); }
#pragma unroll
    for (int o = 1; o < 64; o <<= 1) { qa += __shfl_xor(qa, o); qb += __shfl_xor(qb, o); }
    const float ra = 1.f / sqrtf(qa * (1.f / D) + LN_EPS), rb = 1.f / sqrtf(qb * (1.f / D) + LN_EPS);
    v2u* o8a = (v2u*)oa + lane; v2u* o8b = (v2u*)ob + lane;
    float da[16], db[16];
#pragma unroll
    for (int c = 0; c < 16; ++c) { da[c] = 0.f; db[c] = 0.f; }
#pragma unroll
    for (int j = 0; j < 8; ++j) { const f32x4 ww = ((const f32x4*)w)[lane + 64 * j], bb = ((const f32x4*)b)[lane + 64 * j];
        f32x4 ya, yb;
        ya.x = va[j].x * ra * ww.x + bb.x; ya.y = va[j].y * ra * ww.y + bb.y; ya.z = va[j].z * ra * ww.z + bb.z; ya.w = va[j].w * ra * ww.w + bb.w;
        yb.x = vb[j].x * rb * ww.x + bb.x; yb.y = vb[j].y * rb * ww.y + bb.y; yb.z = vb[j].z * rb * ww.z + bb.z; yb.w = vb[j].w * rb * ww.w + bb.w;
        v2u o; o.x = pk2(ya.x, ya.y); o.y = pk2(ya.z, ya.w); o8a[64 * j] = o;
        v2u p; p.x = pk2(yb.x, yb.y); p.y = pk2(yb.z, yb.w); o8b[64 * j] = p;
#pragma unroll
        for (int i = 0; i < 4; ++i) { const float yai = ya[i], ybi = yb[i];
#pragma unroll
            for (int hh = 0; hh < 2; ++hh) { const v4u w8 = *(const LAS v4u*)(wab + (size_t)(((j * 8 + 2 * i + hh) * 64 + lane) * 16));
#pragma unroll
                for (int d = 0; d < 4; ++d) { const float w0 = bflo(w8[d]), w1 = bfhi(w8[d]);
                    da[8 * hh + 2 * d] += yai * w0; da[8 * hh + 2 * d + 1] += yai * w1; db[8 * hh + 2 * d] += ybi * w0; db[8 * hh + 2 * d + 1] += ybi * w1; } }
            asm volatile("" ::: "memory"); }
    }
#pragma unroll
    for (int c = 0; c < 16; ++c) { da[c] = wave_sum(da[c]); db[c] = wave_sum(db[c]); }
    if (lane == 0) {
#pragma unroll
        for (int q = 0; q < 4; ++q) { *(f32x4*)(aba + 4 * q) = (f32x4){da[4 * q], da[4 * q + 1], da[4 * q + 2], da[4 * q + 3]}; *(f32x4*)(abb + 4 * q) = (f32x4){db[4 * q], db[4 * q + 1], db[4 * q + 2], db[4 * q + 3]}; }
    }
}
__device__ __forceinline__ void ln_rows2_bf16in(const bf16* xa, const bf16* xb, const float* w, const float* b, bf16* oa, bf16* ob, unsigned char* qa8, unsigned char* qb8, float* sta, float* stb, int lane) {
    v4u ra[4], rb[4];
#pragma unroll
    for (int j = 0; j < 4; ++j) { ra[j] = ((const v4u*)xa)[lane + 64 * j]; rb[j] = ((const v4u*)xb)[lane + 64 * j]; }
    float va[32], vb[32];
#pragma unroll
    for (int j = 0; j < 4; ++j)
#pragma unroll
        for (int q = 0; q < 4; ++q) { va[8 * j + 2 * q] = bflo(ra[j][q]); va[8 * j + 2 * q + 1] = bfhi(ra[j][q]); vb[8 * j + 2 * q] = bflo(rb[j][q]); vb[8 * j + 2 * q + 1] = bfhi(rb[j][q]); }
    float sa = 0.f, sb = 0.f;
#pragma unroll
    for (int i = 0; i < 32; ++i) { sa += va[i]; sb += vb[i]; }
#pragma unroll
    for (int o = 1; o < 64; o <<= 1) { sa += __shfl_xor(sa, o); sb += __shfl_xor(sb, o); }
    const float ma = sa * (1.f / D), mb = sb * (1.f / D); float qa = 0.f, qb = 0.f;
#pragma unroll
    for (int i = 0; i < 32; ++i) { va[i] -= ma; vb[i] -= mb; qa += va[i] * va[i]; qb += vb[i] * vb[i]; }
#pragma unroll
    for (int o = 1; o < 64; o <<= 1) { qa += __shfl_xor(qa, o); qb += __shfl_xor(qb, o); }
    const float rsa = 1.f / sqrtf(qa * (1.f / D) + LN_EPS), rsb = 1.f / sqrtf(qb * (1.f / D) + LN_EPS);
#pragma unroll
    for (int j = 0; j < 4; ++j) { const float* wp = w + 8 * (lane + 64 * j); const float* bp = b + 8 * (lane + 64 * j);
        const f32x4 w0 = *(const f32x4*)wp, w1 = *(const f32x4*)(wp + 4), b0 = *(const f32x4*)bp, b1 = *(const f32x4*)(bp + 4);
        v4u o, p;
        o.x = pk2(va[8 * j] * rsa * w0.x + b0.x, va[8 * j + 1] * rsa * w0.y + b0.y); o.y = pk2(va[8 * j + 2] * rsa * w0.z + b0.z, va[8 * j + 3] * rsa * w0.w + b0.w);
        o.z = pk2(va[8 * j + 4] * rsa * w1.x + b1.x, va[8 * j + 5] * rsa * w1.y + b1.y); o.w = pk2(va[8 * j + 6] * rsa * w1.z + b1.z, va[8 * j + 7] * rsa * w1.w + b1.w);
        p.x = pk2(vb[8 * j] * rsb * w0.x + b0.x, vb[8 * j + 1] * rsb * w0.y + b0.y); p.y = pk2(vb[8 * j + 2] * rsb * w0.z + b0.z, vb[8 * j + 3] * rsb * w0.w + b0.w);
        p.z = pk2(vb[8 * j + 4] * rsb * w1.x + b1.x, vb[8 * j + 5] * rsb * w1.y + b1.y); p.w = pk2(vb[8 * j + 6] * rsb * w1.z + b1.z, vb[8 * j + 7] * rsb * w1.w + b1.w);
        ((v4u*)oa)[lane + 64 * j] = o; ((v4u*)ob)[lane + 64 * j] = p;
        float ya[8], yb[8];
        ya[0] = bflo(o.x); ya[1] = bfhi(o.x); ya[2] = bflo(o.y); ya[3] = bfhi(o.y); ya[4] = bflo(o.z); ya[5] = bfhi(o.z); ya[6] = bflo(o.w); ya[7] = bfhi(o.w);
        yb[0] = bflo(p.x); yb[1] = bfhi(p.x); yb[2] = bflo(p.y); yb[3] = bfhi(p.y); yb[4] = bflo(p.z); yb[5] = bfhi(p.z); yb[6] = bflo(p.w); yb[7] = bfhi(p.w);
        float ama = 0.f, amb = 0.f;
#pragma unroll
        for (int i = 0; i < 8; ++i) { ama = fmaxf(ama, fabsf(ya[i])); amb = fmaxf(amb, fabsf(yb[i])); }
#pragma unroll
        for (int o2 = 1; o2 < 32; o2 <<= 1) { ama = fmaxf(ama, __shfl_xor(ama, o2)); amb = fmaxf(amb, __shfl_xor(amb, o2)); }
        const float ia = ama > 0.f ? 119.f / ama : 0.f, ib = amb > 0.f ? 119.f / amb : 0.f;
        unsigned ha = 0u, la = 0u, hb = 0u, lb = 0u;
#pragma unroll
        for (int i = 0; i < 8; ++i) { const int sh = 8 * (i & 3) + 4 * (i >> 2);
            const int qa_ = (int)rintf(ya[i] * ia), qla = ((qa_ + 8) & 15) - 8, qha = (qa_ - qla) >> 4; ha |= (unsigned)(qha & 15) << sh; la |= (unsigned)(qla & 15) << sh;
            const int qb_ = (int)rintf(yb[i] * ib), qlb = ((qb_ + 8) & 15) - 8, qhb = (qb_ - qlb) >> 4; hb |= (unsigned)(qhb & 15) << sh; lb |= (unsigned)(qlb & 15) << sh; }
        ((unsigned*)qa8)[lane + 64 * j] = ha; ((unsigned*)qa8)[256 + lane + 64 * j] = la; ((unsigned*)qb8)[lane + 64 * j] = hb; ((unsigned*)qb8)[256 + lane + 64 * j] = lb;
        if ((lane & 31) == 0) { sta[2 * j + (lane >> 5)] = ama * (1.f / 119.f); stb[2 * j + (lane >> 5)] = amb * (1.f / 119.f); } }
}
__device__ __forceinline__ void p0_prologue(Frame& F, const float* x, const float* mem, const float* lnw, const float* lnb, const float* w_in, const float* lmw, const float* lmb, const float* w_kv, const float* w_out, const float* wq) {
    const int lane_ = fresh_lane(), tid_ = F.wave * 64 + lane_; (void)tid_;
    LAS float* scr = (LAS float*)(F.lds + F.wave * 16384);
    const int gw = F.vcu * NWAVES + F.wave, NGW = F.G * NWAVES;
    bf16* W1T = (bf16*)(F.ws + WS_W1T); bf16* WOT = (bf16*)(F.ws + WS_WOT); bf16* WQT = (bf16*)(F.ws + WS_WQT); bf16* XN = (bf16*)(F.ws + WS_XN);
    constexpr int I_1 = (D / 64) * ((IN_COLS + 31) / 32), I_KV = (D / 64) * (NKV / 32), I_O = (D / 64) * (D / 32), I_Q = I_O;
    constexpr int NITEMS = I_1 + I_KV; (void)I_O; (void)I_Q; (void)WOT; (void)WQT; (void)w_out; (void)wq;
#ifndef REP_P0T
#define REP_P0T 1
#endif
#ifndef REP_P0L
#define REP_P0L 1
#endif
    for (int rp_ = 0; rp_ < REP_P0T; ++rp_)
    for (int it = gw; it < NITEMS; it += NGW) {
        int r = it;
        if (r < I_1) { transpose_item<true>(w_in, D, IN_COLS, W1T, 0, scr, r, lane_); continue; } r -= I_1;
        transpose_item<false>(w_kv, D, NKV, W1T, N1, scr, r, lane_);
    }
    { v4u* z = (v4u*)(W1T + (size_t)6160 * D); const int n16 = 240 * D * 2 / 16; const v4u zero = {0u, 0u, 0u, 0u};
      for (int i = blockIdx.x * NTHREADS + tid_; i < n16; i += F.G * NTHREADS) z[i] = zero; }
    __syncthreads();
    for (int idx = tid_; idx < 8 * 8 * 64; idx += NTHREADS) { const int j = idx >> 9, q = (idx >> 6) & 7, ln = idx & 63; const int e = 4 * (ln + 64 * j) + (q >> 1);
        const float* src = w_in + (size_t)e * IN_COLS + 4096 + 8 * (q & 1); const f32x4 a = *(const f32x4*)src, b2 = *(const f32x4*)(src + 4);
        v4u o; o.x = pk2(a.x, a.y); o.y = pk2(a.z, a.w); o.z = pk2(b2.x, b2.y); o.w = pk2(b2.z, b2.w);
        *(LAS v4u*)(F.lds + (size_t)idx * 16) = o; }
    __syncthreads();
    float* ABp = (float*)(F.ws + WS_AB);
    for (int rp_ = 0; rp_ < REP_P0L; ++rp_)
    for (int m = gw; m < M; m += 2 * NGW) ln_rows2_bf16(x + (size_t)m * D, x + (size_t)(m + NGW) * D, lnw, lnb, XN + (size_t)m * D, XN + (size_t)(m + NGW) * D,
                                                        F.lds, ABp + (size_t)m * 16, ABp + (size_t)(m + NGW) * 16, lane_);
    for (int m = gw; m < BATCH * NMEM; m += NGW) ln_row_bf16(mem + (size_t)m * D, lmw, lmb, XN + (size_t)(M + m) * D, lane_);
}

struct Sched1 {
    pg8::StaticOrder so;
    __device__ void init(int G_, int c_) { so.init(M, PROJ_LD, G_, c_); }
    __device__ bool next(int i, pg8::Unit& u) const { return so.next(i, u); }
    __device__ __forceinline__ void a_ready(const pg8::Unit&) const {}
    __device__ __forceinline__ void done(const pg8::Unit&) const {}
};
struct SchedKV {
    int e;
    __device__ bool next(int i, pg8::Unit& u) const { if (i) return false; u.pm = 64 + (e >> 2); u.pn = 25 + (e & 3); return true; }
    __device__ __forceinline__ void a_ready(const pg8::Unit&) const {}
    __device__ __forceinline__ void done(const pg8::Unit&) const {}
};
struct Epi1 {
    static constexpr bool PERM = true, AFTER_DRAIN = false;
    bf16* PROJ; float* AB; bf16* MKV;
    __device__ __forceinline__ void operator()(const pg8::f32x4 (&acc)[2][2][4][2], const pg8::Unit& u, int wr, int wc, int fr, int fq) const {
        const int rloc = wr * 64 + fr, cloc = wc * 32 + 8 * fq;
        if (u.pm < 64 && u.pn == 24) {
            return;
        }
        bf16* base; int ld;
        if (u.pm < 64) { base = PROJ + (size_t)u.pm * 256 * PROJ_LD + u.pn * 256; ld = PROJ_LD; }
        else { base = MKV + (size_t)(u.pm - 64) * 256 * NKV + (u.pn - 25) * 256; ld = NKV; }
        base += (size_t)rloc * ld + cloc;
#pragma unroll
        for (int ai = 0; ai < 2; ++ai)
#pragma unroll
            for (int m = 0; m < 4; ++m) { bf16* rowp = base + (size_t)(ai * 128 + m * 16) * ld;
#pragma unroll
                for (int bj = 0; bj < 2; ++bj) { const pg8::f32x4 v0 = acc[ai][bj][m][0], v1 = acc[ai][bj][m][1];
                    pg8::u32x4 w; w.x = pg8::cvt_pk_bf16(v0[0], v0[1]); w.y = pg8::cvt_pk_bf16(v0[2], v0[3]); w.z = pg8::cvt_pk_bf16(v1[0], v1[1]); w.w = pg8::cvt_pk_bf16(v1[2], v1[3]);
                    *(pg8::u32x4*)(rowp + bj * 128) = w; } }
    }
};

constexpr int MK_STRIDE = 272;
typedef short bf16x8 __attribute__((ext_vector_type(8)));
typedef short s16x4 __attribute__((ext_vector_type(4)));
typedef float f32x16 __attribute__((ext_vector_type(16)));
#define MFMA32(a, b, c) __builtin_amdgcn_mfma_f32_32x32x16_bf16((a), (b), (c), 0, 0, 0)
__device__ __forceinline__ int crow(int r, int h) { return (r & 3) + 8 * (r >> 2) + 4 * h; }
template <int S> __device__ __forceinline__ bf16x8 pack8(const f32x16& x) {
    v4u p; p.x = cvtpk(x[8 * S], x[8 * S + 1]); p.y = cvtpk(x[8 * S + 2], x[8 * S + 3]); p.z = cvtpk(x[8 * S + 4], x[8 * S + 5]); p.w = cvtpk(x[8 * S + 6], x[8 * S + 7]);
    return __builtin_bit_cast(bf16x8, p);
}
template <int S> __device__ __forceinline__ void pack8_hilo(const f32x16& x, bf16x8& hi, bf16x8& lo) {
    v4u ph, pl;
#pragma unroll
    for (int i = 0; i < 4; ++i) { const float a = x[8 * S + 2 * i], b = x[8 * S + 2 * i + 1]; const unsigned w = cvtpk(a, b); ph[i] = w; pl[i] = cvtpk(a - bflo(w), b - bfhi(w)); }
    hi = __builtin_bit_cast(bf16x8, ph); lo = __builtin_bit_cast(bf16x8, pl);
}
typedef short v4i16_t __attribute__((ext_vector_type(4)));
__device__ __forceinline__ s16x4 tr_read(const LAS unsigned char* p) { return __builtin_bit_cast(s16x4, __builtin_amdgcn_ds_read_tr16_b64_v4i16((LAS v4i16_t*)p)); }
__device__ __forceinline__ bf16x8 cat8(s16x4 lo, s16x4 hi) { return __builtin_shufflevector(lo, hi, 0, 1, 2, 3, 4, 5, 6, 7); }

constexpr int UROW = 1152;
constexpr int OPS_CHUNK = 65536, OPS_W = 0, OPS_U = 16384, OPS_Q = 32768, OPS_K = 49152, QKF_CHUNK = 8192;
constexpr int PR_K = 0, PR_Q = 17408, PR_V = 34816, PR_A = 51200, PR_GC = 67584, PR_HALF = 68608;
__device__ __forceinline__ void prep_tile(int which, int ti, int tj, const LAS unsigned char* Kl, const LAS unsigned char* Ql, LAS float* Am, const LAS float* gcl, const LAS float* betl,
                                          unsigned char* qkf, int lane, int c, int h) {
    const bool zero_tile = which ? (ti == 1 && tj == 0) : (ti == 0 && tj == 1);
    f32x16 acc;
#pragma unroll
    for (int r = 0; r < 16; ++r) acc[r] = 0.f;
    if (!zero_tile) {
        const LAS unsigned char* Bl = which ? Ql : Kl;
#pragma unroll
        for (int ks = 0; ks < 8; ++ks) {
            const bf16x8 af = *(const LAS bf16x8*)(Kl + (32 * ti + c) * MK_STRIDE + (16 * ks + 8 * h) * 2);
            const bf16x8 bf = *(const LAS bf16x8*)(Bl + (32 * tj + c) * MK_STRIDE + (16 * ks + 8 * h) * 2);
            acc = MFMA32(af, bf, acc);
        }
    }
    const int col = 32 * tj + c; const float gcol = gcl[col];
    if (which == 0) {
        if (!zero_tile) {
#pragma unroll
            for (int r = 0; r < 16; ++r) { const int i = 32 * ti + crow(r, h);
                Am[i * 64 + col] = (col < i) ? betl[i] * acc[r] * __expf(gcl[i] - gcol) : 0.f; }
        }
    } else {
#pragma unroll
        for (int r = 0; r < 16; ++r) { const int jj = 32 * ti + crow(r, h);
            acc[r] = (jj <= col) ? acc[r] * __expf(gcol - gcl[jj]) : 0.f; }
        *(bf16x8*)(qkf + (((tj * 2 + ti) * 2 + 0) * 64 + lane) * 16) = pack8<0>(acc);
        *(bf16x8*)(qkf + (((tj * 2 + ti) * 2 + 1) * 64 + lane) * 16) = pack8<1>(acc);
    }
}
template <bool ISW> __device__ __forceinline__ void prep_subst(float (&X)[64], const LAS float* Amz, const LAS float* bz, const LAS float* ez, const LAS unsigned char* Rb, const int rstride) {
#pragma unroll
    for (int i = 0; i < 64; ++i) {
        const float sc = ISW ? bz[i] * ez[i] : bz[i];
        float a0 = sc * bf2f(*(const LAS bf16*)(Rb + i * rstride)), a1 = 0.f, a2 = 0.f, a3 = 0.f;
#pragma unroll
        for (int j4 = 0; j4 < (i + 3) / 4; ++j4) { const f32x4 a4 = *(const LAS f32x4*)(Amz + i * 64 + 4 * j4);
            if (4 * j4 < i) a0 -= a4.x * X[4 * j4];
            if (4 * j4 + 1 < i) a1 -= a4.y * X[4 * j4 + 1];
            if (4 * j4 + 2 < i) a2 -= a4.z * X[4 * j4 + 2];
            if (4 * j4 + 3 < i) a3 -= a4.w * X[4 * j4 + 3]; }
        X[i] = (a0 + a1) + (a2 + a3);
        if ((i & 1) == 1) asm volatile("" : "+v"(X[i]) :: "memory");
    }
}
__device__ __forceinline__ void gdn_prep_pair(Frame& F, int pair, const float* cw, const float* a_log, const float* dt_bias) {
    const int lane = fresh_lane(), wave = F.wave, gq = wave >> 2, lw = wave & 3, ltid = lw * 64 + lane, c = lane & 31, h = lane >> 5;
    const int unit = 2 * pair + gq;
    const int n = unit & 63, bh = unit >> 6, b = bh >> 3, hd = bh & 7;
    const bf16* PROJ = (const bf16*)(F.ws + WS_PROJ); const float* AB = (const float*)(F.ws + WS_AB);
    unsigned char* ops = (unsigned char*)F.out + (size_t)unit * OPS_CHUNK; unsigned char* qkf = F.ws + WS_QKF + (size_t)unit * QKF_CHUNK; float* GL = (float*)(F.ws + WS_GL);
    LAS unsigned char* L0 = F.lds + gq * PR_HALF;
    LAS unsigned char* Kl = L0 + PR_K; LAS unsigned char* Ql = L0 + PR_Q; LAS unsigned char* Vl = L0 + PR_V; LAS float* Am = (LAS float*)(L0 + PR_A);
    LAS float* gcl = (LAS float*)(L0 + PR_GC); LAS float* betl = gcl + 64; LAS float* egl = gcl + 128;
    const size_t row0 = (size_t)b * SEQ + 64 * n; const int t0 = 64 * n;
    __syncthreads();
    if (lw == 0) {
        const float a = AB[(row0 + lane) * 16 + hd], bb = AB[(row0 + lane) * 16 + 8 + hd];
        float g = -__expf(a_log[hd]) * softplus_f(a + dt_bias[hd]);
#pragma unroll
        for (int o = 1; o < 64; o <<= 1) { const float t = __shfl_up(g, o); if (lane >= o) g += t; }
        gcl[lane] = g; betl[lane] = sigmoid_f(bb); egl[lane] = __expf(g);
    }
    float y[3][16][2];
#pragma unroll
    for (int p = 0; p < 3; ++p) {
        const int ch = p * 1024 + hd * 128 + 2 * lane;
        float w0[4], w1[4];
#pragma unroll
        for (int i = 0; i < 4; ++i) { w0[i] = cw[i * QKV_LD + ch]; w1[i] = cw[i * QKV_LD + ch + 1]; }
        float x0[19], x1[19];
#pragma unroll
        for (int j = 0; j < 19; ++j) { const int tt = t0 + 16 * lw - 3 + j;
            unsigned x2 = 0u; if (tt >= 0) x2 = *(const unsigned*)(PROJ + (row0 + 16 * lw - 3 + j) * PROJ_LD + ch);
            x0[j] = bflo(x2); x1[j] = bfhi(x2); }
#pragma unroll
        for (int r = 0; r < 16; ++r) { float a0 = 0.f, a1 = 0.f;
#pragma unroll
            for (int i = 0; i < 4; ++i) { a0 += w0[i] * x0[r + i]; a1 += w1[i] * x1[r + i]; }
            y[p][r][0] = silu_f(a0); y[p][r][1] = silu_f(a1); }
    }
    {
        float ssq[32];
#pragma unroll
        for (int r = 0; r < 16; ++r) { ssq[r] = y[0][r][0] * y[0][r][0] + y[0][r][1] * y[0][r][1]; ssq[16 + r] = y[1][r][0] * y[1][r][0] + y[1][r][1] * y[1][r][1]; }
#pragma unroll
        for (int o = 1; o < 64; o <<= 1) {
#pragma unroll
            for (int r = 0; r < 32; ++r) ssq[r] += __shfl_xor(ssq[r], o); }
#pragma unroll
        for (int r = 0; r < 16; ++r) { const float qs = rsqrtf(ssq[r] + RMS_EPS) * 0.08838834764831845f, ks = rsqrtf(ssq[16 + r] + RMS_EPS);
            y[0][r][0] *= qs; y[0][r][1] *= qs; y[1][r][0] *= ks; y[1][r][1] *= ks; }
    }
    __syncthreads();
    const float glast = gcl[63];
#pragma unroll
    for (int r = 0; r < 16; ++r) {
        const int i = 16 * lw + r; const float eg = egl[i], gi = gcl[i];
        *(LAS unsigned*)(Ql + i * MK_STRIDE + 4 * lane) = pk2(y[0][r][0], y[0][r][1]);
        *(LAS unsigned*)(Kl + i * MK_STRIDE + 4 * lane) = pk2(y[1][r][0], y[1][r][1]);
        *(LAS unsigned*)(Vl + i * 256 + 4 * lane) = pk2(y[2][r][0], y[2][r][1]);
        const float ek = __expf(glast - gi);
        *(unsigned*)(ops + OPS_Q + i * 256 + 4 * lane) = pk2(y[0][r][0] * eg, y[0][r][1] * eg);
        *(unsigned*)(ops + OPS_K + i * 256 + 4 * lane) = pk2(y[1][r][0] * ek, y[1][r][1] * ek);
    }
    if (ltid == 0) GL[unit] = __expf(glast);
    __syncthreads();
    if (lw == 0) { prep_tile(0, 0, 0, Kl, Ql, Am, gcl, betl, qkf, lane, c, h); prep_tile(0, 1, 1, Kl, Ql, Am, gcl, betl, qkf, lane, c, h); }
    else if (lw == 1) { prep_tile(0, 1, 0, Kl, Ql, Am, gcl, betl, qkf, lane, c, h); prep_tile(1, 0, 0, Kl, Ql, Am, gcl, betl, qkf, lane, c, h); }
    else if (lw == 2) { prep_tile(1, 0, 1, Kl, Ql, Am, gcl, betl, qkf, lane, c, h); prep_tile(1, 1, 1, Kl, Ql, Am, gcl, betl, qkf, lane, c, h); }
    else { prep_tile(1, 1, 0, Kl, Ql, Am, gcl, betl, qkf, lane, c, h); }
    __syncthreads();
    {
        const int cc = ltid & 127; const bool isw = lw >= 2;
        int zl = 0; asm volatile("" : "+v"(zl));
        const LAS float* Amz = Am + zl; const LAS float* bz = betl + zl; const LAS float* ez = egl + zl;
        float X[64];
        if (isw) prep_subst<true>(X, Amz, bz, ez, Kl + 2 * cc, MK_STRIDE); else prep_subst<false>(X, Amz, bz, ez, Vl + 2 * cc, 256);
        if (!isw) {
            const int sl = cc >> 5, c_ = cc & 31;
#pragma unroll
            for (int h_ = 0; h_ < 2; ++h_) {
                unsigned wds[16];
#pragma unroll
                for (int rt = 0; rt < 2; ++rt)
#pragma unroll
                    for (int rp = 0; rp < 8; ++rp) { const int r0 = 2 * rp, r1 = 2 * rp + 1;
                        wds[rt * 8 + rp] = pk2(X[32 * rt + (r0 & 3) + 8 * (r0 >> 2) + 4 * h_], X[32 * rt + (r1 & 3) + 8 * (r1 >> 2) + 4 * h_]); }
                v4u* dst = (v4u*)(ops + OPS_U + ((sl * 64 + c_ + 32 * h_) * 64));
#pragma unroll
                for (int q = 0; q < 4; ++q) { v4u o; o.x = wds[4 * q]; o.y = wds[4 * q + 1]; o.z = wds[4 * q + 2]; o.w = wds[4 * q + 3]; dst[q] = o; }
            }
        } else {
#pragma unroll
            for (int i = 0; i < 64; ++i) *(bf16*)(ops + OPS_W + i * 256 + 2 * cc) = (bf16)f2bf(-X[i]);
        }
    }
}

constexpr int SC_W = 0, SC_Q = 16896, SC_K = 33792, SC_QKF = 54272, SC_BUF = 62464, SC_OBUF = 2 * SC_BUF, SC_OSTRIDE = 272, SC_OBYTES = 64 * SC_OSTRIDE;
__device__ __forceinline__ void gdn_scan_unit(Frame& F, int bh, const float* gnw) {
    const int lane = fresh_lane(), wave = F.wave, c = lane & 31, h = lane >> 5;
    const int b = bh >> 3, hd = bh & 7;
    const bf16* PROJ = (const bf16*)(F.ws + WS_PROJ); bf16* OMIX = (bf16*)(F.ws + WS_OMIX);
    const unsigned char* ops0 = (unsigned char*)F.out + (size_t)bh * 64 * OPS_CHUNK; const unsigned char* qkf0 = F.ws + WS_QKF + (size_t)bh * 64 * QKF_CHUNK; const float* GL = (const float*)(F.ws + WS_GL) + bh * 64;
    const size_t rowb = (size_t)b * SEQ;
    __syncthreads();
    if (wave >= 4) {
        const int lw = wave - 4;
        const int r4 = lane >> 4, c8 = lane & 15;
        float gw8[8];
#pragma unroll
        for (int e = 0; e < 8; ++e) gw8[e] = gnw[8 * c8 + e];
        v4u a0[4], q0[4], k0[4], f0[2], a1[4], q1[4], k1[4], f1[2];
        v4u zA[4], zB[4];
#define LD_ISSUE(A, Q, K, Fq, nn) do { if ((nn) < 64) { const int ltid = lw * 64 + fresh_lane(); const unsigned char* src_ = ops0 + (size_t)(nn) * OPS_CHUNK; \
            _Pragma("unroll") for (int k_ = 0; k_ < 4; ++k_) { const int i_ = ltid + 256 * k_; A[k_] = *(const v4u*)(src_ + OPS_W + i_ * 16); Q[k_] = *(const v4u*)(src_ + OPS_Q + i_ * 16); K[k_] = *(const v4u*)(src_ + OPS_K + i_ * 16); } \
            _Pragma("unroll") for (int k_ = 0; k_ < 2; ++k_) Fq[k_] = *(const v4u*)(qkf0 + (size_t)(nn) * QKF_CHUNK + (ltid + 256 * k_) * 16); } } while (0)
#define LD_STORE(A, Q, K, Fq, nn) do { if ((nn) < 64) { const int ltid = lw * 64 + fresh_lane(); LAS unsigned char* dst_ = F.lds + ((nn) & 1) * SC_BUF; \
            _Pragma("unroll") for (int k_ = 0; k_ < 4; ++k_) { const int i_ = ltid + 256 * k_, r_ = i_ >> 4, ch_ = i_ & 15; \
                *(LAS v2u*)(dst_ + SC_W + r_ * 264 + ch_ * 16) = (v2u){A[k_].x, A[k_].y}; *(LAS v2u*)(dst_ + SC_W + r_ * 264 + ch_ * 16 + 8) = (v2u){A[k_].z, A[k_].w}; \
                *(LAS v2u*)(dst_ + SC_Q + r_ * 264 + ch_ * 16) = (v2u){Q[k_].x, Q[k_].y}; *(LAS v2u*)(dst_ + SC_Q + r_ * 264 + ch_ * 16 + 8) = (v2u){Q[k_].z, Q[k_].w}; \
                *(LAS v4u*)(dst_ + SC_K + r_ * 320 + ch_ * 16) = K[k_]; } \
            _Pragma("unroll") for (int k_ = 0; k_ < 2; ++k_) *(LAS v4u*)(dst_ + SC_QKF + (ltid + 256 * k_) * 16) = Fq[k_]; } } while (0)
#define Z_ISSUE(Z, mm) do { const size_t rowc_ = rowb + 64 * (mm) + 16 * lw + r4; \
            _Pragma("unroll") for (int g = 0; g < 4; ++g) Z[g] = *(const v4u*)(PROJ + (rowc_ + 4 * g) * PROJ_LD + 3072 + hd * 128 + 8 * c8); } while (0)
#define FINISH(mm, Z) do { const LAS unsigned char* ob = F.lds + SC_OBUF + ((mm) & 1) * SC_OBYTES; const size_t rowc_ = rowb + 64 * (mm) + 16 * lw + r4; \
            _Pragma("unroll") for (int g = 0; g < 4; ++g) { const v4u w = *(const LAS v4u*)(ob + (16 * lw + 4 * g + r4) * SC_OSTRIDE + 16 * c8); \
                float ov[8]; ov[0] = bflo(w.x); ov[1] = bfhi(w.x); ov[2] = bflo(w.y); ov[3] = bfhi(w.y); ov[4] = bflo(w.z); ov[5] = bfhi(w.z); ov[6] = bflo(w.w); ov[7] = bfhi(w.w); \
                float ss = 0.f; _Pragma("unroll") for (int e = 0; e < 8; ++e) ss += ov[e] * ov[e]; \
                ss += __shfl_xor(ss, 1); ss += __shfl_xor(ss, 2); ss += __shfl_xor(ss, 4); ss += __shfl_xor(ss, 8); \
                const float rinv = rsqrtf(ss * (1.f / HD) + RMS_EPS); const v4u zz = Z[g]; \
                float zf[8]; zf[0] = bflo(zz.x); zf[1] = bfhi(zz.x); zf[2] = bflo(zz.y); zf[3] = bfhi(zz.y); zf[4] = bflo(zz.z); zf[5] = bfhi(zz.z); zf[6] = bflo(zz.w); zf[7] = bfhi(zz.w); \
                v4u ow; ow.x = pk2(ov[0] * rinv * gw8[0] * silu_f(zf[0]), ov[1] * rinv * gw8[1] * silu_f(zf[1])); ow.y = pk2(ov[2] * rinv * gw8[2] * silu_f(zf[2]), ov[3] * rinv * gw8[3] * silu_f(zf[3])); \
                ow.z = pk2(ov[4] * rinv * gw8[4] * silu_f(zf[4]), ov[5] * rinv * gw8[5] * silu_f(zf[5])); ow.w = pk2(ov[6] * rinv * gw8[6] * silu_f(zf[6]), ov[7] * rinv * gw8[7] * silu_f(zf[7])); \
                *(v4u*)(OMIX + (rowc_ + 4 * g) * D + hd * 128 + 8 * c8) = ow; } } while (0)
#define SC_ITER(nn, SA, SQ, SK, SF, IA, IQ, IK, IF, ZI, ZU) do { LD_STORE(SA, SQ, SK, SF, (nn) + 1); LD_ISSUE(IA, IQ, IK, IF, (nn) + 2); Z_ISSUE(ZI, (nn)); \
            if ((nn) >= 1) FINISH((nn) - 1, ZU); __syncthreads(); } while (0)
        LD_ISSUE(a0, q0, k0, f0, 0); LD_STORE(a0, q0, k0, f0, 0); LD_ISSUE(a1, q1, k1, f1, 1);
        __syncthreads();
        for (int n = 0; n < 64; n += 2) {
            SC_ITER(n, a1, q1, k1, f1, a0, q0, k0, f0, zA, zB);
            SC_ITER(n + 1, a0, q0, k0, f0, a1, q1, k1, f1, zB, zA);
        }
        FINISH(63, zB);
#undef SC_ITER
#undef FINISH
#undef Z_ISSUE
#undef LD_STORE
#undef LD_ISSUE
    } else {
        __builtin_amdgcn_s_setprio(3);
        f32x16 S[4];
#pragma unroll
        for (int d = 0; d < 4; ++d)
#pragma unroll
            for (int r = 0; r < 16; ++r) S[d][r] = 0.f;
        v4u un[4]; float gl_n;
        { const v4u* up = (const v4u*)(ops0 + OPS_U + (wave * 64 + lane) * 64);
#pragma unroll
          for (int q = 0; q < 4; ++q) un[q] = up[q];
          gl_n = GL[0]; }
        __syncthreads();
        for (int n = 0; n < 64; ++n) {
            const LAS unsigned char* B_ = F.lds + (n & 1) * SC_BUF;
            LAS unsigned char* ob = F.lds + SC_OBUF + (n & 1) * SC_OBYTES;
            f32x16 vn[2]; const float gl = gl_n;
#pragma unroll
            for (int rt = 0; rt < 2; ++rt)
#pragma unroll
                for (int rp = 0; rp < 8; ++rp) { const unsigned w = un[(rt * 8 + rp) >> 2][(rt * 8 + rp) & 3]; vn[rt][2 * rp] = bflo(w); vn[rt][2 * rp + 1] = bfhi(w); }
            if (n + 1 < 64) { const v4u* up = (const v4u*)(ops0 + (size_t)(n + 1) * OPS_CHUNK + OPS_U + (wave * 64 + lane) * 64);
#pragma unroll
                for (int q = 0; q < 4; ++q) un[q] = up[q];
                gl_n = GL[n + 1]; }
            f32x16 o[2];
#pragma unroll
            for (int rt = 0; rt < 2; ++rt)
#pragma unroll
                for (int r = 0; r < 16; ++r) o[rt][r] = 0.f;
            const LAS unsigned char* wp = B_ + SC_W + c * 264 + 8 * h; const LAS unsigned char* qp = B_ + SC_Q + c * 264 + 8 * h;
#define SC_KSTEP(ks) do { const bf16x8 sf_ = pack8<(ks) & 1>(S[(ks) >> 1]); \
                _Pragma("unroll") for (int rt = 0; rt < 2; ++rt) { \
                    const s16x4 w0 = *(const LAS s16x4*)(wp + rt * 32 * 264 + 32 * (ks)), w1 = *(const LAS s16x4*)(wp + rt * 32 * 264 + 32 * (ks) + 16); \
                    vn[rt] = MFMA32(cat8(w0, w1), sf_, vn[rt]); \
                    const s16x4 q0 = *(const LAS s16x4*)(qp + rt * 32 * 264 + 32 * (ks)), q1 = *(const LAS s16x4*)(qp + rt * 32 * 264 + 32 * (ks) + 16); \
                    o[rt] = MFMA32(cat8(q0, q1), sf_, o[rt]); } } while (0)
            SC_KSTEP(0); SC_KSTEP(1); SC_KSTEP(2); SC_KSTEP(3);
            SC_KSTEP(4); SC_KSTEP(5); SC_KSTEP(6); SC_KSTEP(7); __builtin_amdgcn_sched_barrier(0);
#undef SC_KSTEP
            bf16x8 vf[4]; vf[0] = pack8<0>(vn[0]); vf[1] = pack8<1>(vn[0]); vf[2] = pack8<0>(vn[1]); vf[3] = pack8<1>(vn[1]);
#pragma unroll
            for (int to = 0; to < 2; ++to)
#pragma unroll
                for (int kk = 0; kk < 4; ++kk) {
                    const bf16x8 qa = *(const LAS bf16x8*)(B_ + SC_QKF + ((((to * 2 + (kk >> 1)) * 2 + (kk & 1)) * 64 + lane) * 16));
                    o[to] = MFMA32(qa, vf[kk], o[to]);
                }
#pragma unroll
            for (int rt = 0; rt < 2; ++rt)
#pragma unroll
                for (int r = 0; r < 16; ++r) *(LAS bf16*)(ob + (32 * rt + crow(r, h)) * SC_OSTRIDE + (32 * wave + c) * 2) = (bf16)f2bf(o[rt][r]);
            __builtin_amdgcn_sched_barrier(0);
            const LAS unsigned char* kb = B_ + SC_K + (4 * h + ((lane & 15) >> 2)) * 320 + (((lane >> 4) & 1) * 16 + (lane & 3) * 4) * 2;
#pragma unroll
            for (int dt = 0; dt < 4; ++dt) {
#pragma unroll
                for (int r = 0; r < 16; ++r) S[dt][r] *= gl;
#pragma unroll
                for (int kk = 0; kk < 4; ++kk) {
                    const s16x4 lo = tr_read(kb + (16 * kk) * 320 + dt * 64), hi = tr_read(kb + (16 * kk + 8) * 320 + dt * 64);
                    S[dt] = MFMA32(cat8(lo, hi), vf[kk], S[dt]);
                }
            }
            __syncthreads();
        }
        __builtin_amdgcn_s_setprio(0);
    }
}

constexpr int SBK_STRIDE = 272, SBV_STRIDE = 320, SB_KBYTES = 64 * SBK_STRIDE, SB_VBYTES = 64 * SBV_STRIDE, SB_BUF = SB_KBYTES + SB_VBYTES, SB_FLAGS_OFF = 2 * SB_BUF;
__device__ __forceinline__ void sb_unit(Frame& F, int unit, const float* sb_norm_w) {
    const int lane_ = fresh_lane(), tid_ = F.wave * 64 + lane_; (void)tid_;
    const int qb = unit & 15, bh = unit >> 4, b = bh >> 2, hh = bh & 3;
    const int tid = tid_, lane = lane_, wave = F.wave, c = lane & 31, h = lane >> 5;
    const bf16* PROJ = (const bf16*)(F.ws + WS_PROJ); bf16* OMIX = (bf16*)(F.ws + WS_OMIX);
    const size_t rowb = (size_t)b * SEQ;
    const bf16* Qp = PROJ + 4096 + hh * 128; const bf16* Kp = Qp + 512; const bf16* Vp = Qp + 1024;
    const int q0w = qb * 256 + wave * 32;
    bf16x8 qf[8];
#pragma unroll
    for (int ks = 0; ks < 8; ++ks) qf[ks] = *(const bf16x8*)(Qp + (rowb + q0w + c) * PROJ_LD + 16 * ks + 8 * h);
    bf16x8 U0, U1, ONES;
#pragma unroll
    for (int j = 0; j < 8; ++j) { const int jin = 8 * (j >> 2) + 4 * h + (j & 3); U0[j] = (jin > c) ? (short)0x3F80 : (short)0; U1[j] = (16 + jin > c) ? (short)0x3F80 : (short)0; ONES[j] = (short)0x3F80; }
    f32x16 o[4];
#pragma unroll
    for (int d = 0; d < 4; ++d)
#pragma unroll
        for (int r = 0; r < 16; ++r) o[d][r] = 0.f;
    float carry = 0.f; bool wdone = false;
    LAS volatile int* flags = (LAS volatile int*)(F.lds + SB_FLAGS_OFF);
    const int kt0 = 4 * qb + 3;
    const int srow0 = tid >> 4, sch = tid & 15;
    v4u kr[2], vr[2];
#define SB_LOAD(kt) do { _Pragma("unroll") for (int i_ = 0; i_ < 2; ++i_) { const size_t go = (rowb + 64 * (kt) + srow0 + 32 * i_) * PROJ_LD + 8 * sch; kr[i_] = *(const v4u*)(Kp + go); vr[i_] = *(const v4u*)(Vp + go); } } while (0)
#define SB_STORE(buf) do { _Pragma("unroll") for (int i_ = 0; i_ < 2; ++i_) { *(LAS v4u*)(F.lds + (buf) * SB_BUF + (srow0 + 32 * i_) * SBK_STRIDE + 16 * sch) = kr[i_]; *(LAS v4u*)(F.lds + (buf) * SB_BUF + SB_KBYTES + (srow0 + 32 * i_) * SBV_STRIDE + 16 * sch) = vr[i_]; } } while (0)
    __syncthreads();
    SB_LOAD(kt0); SB_STORE(0);
    __syncthreads();
    for (int it = 0;; ++it) {
        const int kt = kt0 - it, buf = it & 1;
        if (kt > 0) SB_LOAD(kt - 1);
        const bool active = !wdone && (64 * kt <= q0w + 30);
        if (active) {
            const LAS unsigned char* Kt = F.lds + buf * SB_BUF; const LAS unsigned char* Vt = Kt + SB_KBYTES;
            const int qg = q0w + c, kbase = 64 * kt + 4 * h;
            f32x16 cb;
#pragma unroll
            for (int r = 0; r < 16; ++r) cb[r] = carry;
            bf16x8 pa[4];
            f32x16 T1;
            {
                f32x16 p1;
#pragma unroll
                for (int r = 0; r < 16; ++r) p1[r] = 0.f;
#pragma unroll
                for (int ks = 0; ks < 8; ++ks) p1 = MFMA32(*(const LAS bf16x8*)(Kt + (c + 32) * SBK_STRIDE + (16 * ks + 8 * h) * 2), qf[ks], p1);
                f32x16 l1;
#pragma unroll
                for (int r = 0; r < 16; ++r) { const int key = kbase + 32 + (r & 3) + 8 * (r >> 2); const float z = p1[r] * 0.08838834764831845f;
                    const float e = __expf(z); const float sp = z > 20.f ? z : __logf(1.f + e); l1[r] = (key < qg) ? -sp : 0.f; p1[r] = z - sp; }
                bf16x8 Lh0, Ll0, Lh1, Ll1; pack8_hilo<0>(l1, Lh0, Ll0); pack8_hilo<1>(l1, Lh1, Ll1);
                T1 = MFMA32(ONES, Lh0, cb); T1 = MFMA32(ONES, Ll0, T1); T1 = MFMA32(ONES, Lh1, T1); T1 = MFMA32(ONES, Ll1, T1);
                f32x16 A1 = MFMA32(U0, Lh0, cb); A1 = MFMA32(U0, Ll0, A1); A1 = MFMA32(U1, Lh1, A1); A1 = MFMA32(U1, Ll1, A1);
#pragma unroll
                for (int r = 0; r < 16; ++r) { const int key = kbase + 32 + (r & 3) + 8 * (r >> 2); p1[r] = (key < qg) ? __expf(p1[r] + A1[r]) : 0.f; }
                pa[2] = pack8<0>(p1); pa[3] = pack8<1>(p1);
            }
            {
                f32x16 p0;
#pragma unroll
                for (int r = 0; r < 16; ++r) p0[r] = 0.f;
#pragma unroll
                for (int ks = 0; ks < 8; ++ks) p0 = MFMA32(*(const LAS bf16x8*)(Kt + c * SBK_STRIDE + (16 * ks + 8 * h) * 2), qf[ks], p0);
                f32x16 l0;
#pragma unroll
                for (int r = 0; r < 16; ++r) { const int key = kbase + (r & 3) + 8 * (r >> 2); const float z = p0[r] * 0.08838834764831845f;
                    const float e = __expf(z); const float sp = z > 20.f ? z : __logf(1.f + e); l0[r] = (key < qg) ? -sp : 0.f; p0[r] = z - sp; }
                bf16x8 Lh0, Ll0, Lh1, Ll1; pack8_hilo<0>(l0, Lh0, Ll0); pack8_hilo<1>(l0, Lh1, Ll1);
                f32x16 A0 = MFMA32(U0, Lh0, T1); A0 = MFMA32(U0, Ll0, A0); A0 = MFMA32(U1, Lh1, A0); A0 = MFMA32(U1, Ll1, A0);
                T1 = MFMA32(ONES, Lh0, T1); T1 = MFMA32(ONES, Ll0, T1); T1 = MFMA32(ONES, Lh1, T1); T1 = MFMA32(ONES, Ll1, T1);
                carry = T1[0];
#pragma unroll
                for (int r = 0; r < 16; ++r) { const int key = kbase + (r & 3) + 8 * (r >> 2); p0[r] = (key < qg) ? __expf(p0[r] + A0[r]) : 0.f; }
                pa[0] = pack8<0>(p0); pa[1] = pack8<1>(p0);
            }
            const LAS unsigned char* vb = Vt + (4 * h + ((lane & 15) >> 2)) * SBV_STRIDE + (((lane >> 4) & 1) * 16 + (lane & 3) * 4) * 2;
#pragma unroll
            for (int dt = 0; dt < 4; ++dt)
#pragma unroll
                for (int kv = 0; kv < 4; ++kv) {
                    const s16x4 lo = tr_read(vb + (16 * kv) * SBV_STRIDE + dt * 64), hi = tr_read(vb + (16 * kv + 8) * SBV_STRIDE + dt * 64);
                    o[dt] = MFMA32(pa[kv], cat8(lo, hi), o[dt]);
                }
            wdone = __all(carry < -30.f);
        }
        if (lane == 0) flags[buf * 8 + wave] = wdone ? 1 : 0;
        if (kt > 0) SB_STORE(buf ^ 1);
        __syncthreads();
        if (kt == 0) break;
        int alld = 1;
#pragma unroll
        for (int w = 0; w < 8; ++w) alld &= flags[buf * 8 + w];
        if (alld) break;
    }
#undef SB_LOAD
#undef SB_STORE
    float rinv[16];
#pragma unroll
    for (int r = 0; r < 16; ++r) { float ss = o[0][r] * o[0][r] + o[1][r] * o[1][r] + o[2][r] * o[2][r] + o[3][r] * o[3][r];
        ss += __shfl_xor(ss, 1); ss += __shfl_xor(ss, 2); ss += __shfl_xor(ss, 4); ss += __shfl_xor(ss, 8); ss += __shfl_xor(ss, 16);
        rinv[r] = rsqrtf(ss * (1.f / HD) + RMS_EPS); }
#pragma unroll
    for (int dt = 0; dt < 4; ++dt) { const float nw = sb_norm_w[hh * 128 + 32 * dt + c];
#pragma unroll
        for (int r = 0; r < 16; ++r) OMIX[(rowb + q0w + crow(r, h)) * D + 1024 + hh * 128 + 32 * dt + c] = (bf16)f2bf(o[dt][r] * rinv[r] * nw); }
}

constexpr int MEM_KBYTES = 256 * SBK_STRIDE, MEM_VBYTES = 256 * SBV_STRIDE, MEM_SCR_OFF = MEM_KBYTES + MEM_VBYTES;
__device__ __forceinline__ void mem_unit(Frame& F, int unit, const float* mem_norm_w) {
    const int lane_ = fresh_lane(), tid_ = F.wave * 64 + lane_; (void)tid_;
    const int tb = unit & 15, bh = unit >> 4, b = bh >> 2, hh = bh & 3;
    const int tid = tid_, lane = lane_, wave = F.wave, c = lane & 31, h = lane >> 5;
    const bf16* PROJ = (const bf16*)(F.ws + WS_PROJ); const bf16* MKV = (const bf16*)(F.ws + WS_MKV); bf16* OMIX = (bf16*)(F.ws + WS_OMIX);
    const LAS unsigned char* Kl = F.lds; const LAS unsigned char* Vl = F.lds + MEM_KBYTES;
    LAS float* scr = (LAS float*)(F.lds + MEM_SCR_OFF) + wave * 32;
    const size_t row0 = (size_t)b * SEQ + tb * 256 + wave * 32;
    __syncthreads();
    for (int i = tid; i < 256 * 16; i += NTHREADS) { const int r = i >> 4, ch = i & 15;
        const v4u kv = *(const v4u*)(MKV + (size_t)(b * NMEM + r) * NKV + hh * 128 + 8 * ch);
        const v4u vv = *(const v4u*)(MKV + (size_t)(b * NMEM + r) * NKV + 512 + hh * 128 + 8 * ch);
        *(LAS v4u*)(F.lds + r * SBK_STRIDE + 16 * ch) = kv; *(LAS v4u*)(F.lds + MEM_KBYTES + r * SBV_STRIDE + 16 * ch) = vv; }
    bf16x8 qf[8];
#pragma unroll
    for (int ks = 0; ks < 8; ++ks) qf[ks] = *(const bf16x8*)(PROJ + (row0 + c) * PROJ_LD + 5632 + hh * 128 + 16 * ks + 8 * h);
    __syncthreads();
    float m = -INFINITY;
    for (int kt = 0; kt < 4; ++kt) {
        f32x16 p0, p1;
#pragma unroll
        for (int r = 0; r < 16; ++r) { p0[r] = 0.f; p1[r] = 0.f; }
#pragma unroll
        for (int ks = 0; ks < 8; ++ks) {
            const bf16x8 a0 = *(const LAS bf16x8*)(Kl + (64 * kt + c) * SBK_STRIDE + (16 * ks + 8 * h) * 2);
            const bf16x8 a1 = *(const LAS bf16x8*)(Kl + (64 * kt + 32 + c) * SBK_STRIDE + (16 * ks + 8 * h) * 2);
            p0 = MFMA32(a0, qf[ks], p0); p1 = MFMA32(a1, qf[ks], p1);
        }
#pragma unroll
        for (int r = 0; r < 16; ++r) m = fmaxf(m, fmaxf(p0[r], p1[r]));
    }
    m = fmaxf(m, __shfl_xor(m, 32));
    f32x16 o[4];
#pragma unroll
    for (int d = 0; d < 4; ++d)
#pragma unroll
        for (int r = 0; r < 16; ++r) o[d][r] = 0.f;
    float psum = 0.f;
    const LAS unsigned char* vb = Vl + (4 * h + ((lane & 15) >> 2)) * SBV_STRIDE + (((lane >> 4) & 1) * 16 + (lane & 3) * 4) * 2;
    for (int kt = 0; kt < 4; ++kt) {
        f32x16 p0, p1;
#pragma unroll
        for (int r = 0; r < 16; ++r) { p0[r] = -m; p1[r] = -m; }
#pragma unroll
        for (int ks = 0; ks < 8; ++ks) {
            const bf16x8 a0 = *(const LAS bf16x8*)(Kl + (64 * kt + c) * SBK_STRIDE + (16 * ks + 8 * h) * 2);
            const bf16x8 a1 = *(const LAS bf16x8*)(Kl + (64 * kt + 32 + c) * SBK_STRIDE + (16 * ks + 8 * h) * 2);
            p0 = MFMA32(a0, qf[ks], p0); p1 = MFMA32(a1, qf[ks], p1);
        }
#pragma unroll
        for (int r = 0; r < 16; ++r) { p0[r] = __expf(p0[r] * 0.08838834764831845f); p1[r] = __expf(p1[r] * 0.08838834764831845f); psum += p0[r] + p1[r]; }
        bf16x8 pa[4]; pa[0] = pack8<0>(p0); pa[1] = pack8<1>(p0); pa[2] = pack8<0>(p1); pa[3] = pack8<1>(p1);
#pragma unroll
        for (int dt = 0; dt < 4; ++dt)
#pragma unroll
            for (int kv = 0; kv < 4; ++kv) {
                const s16x4 lo = tr_read(vb + (64 * kt + 16 * kv) * SBV_STRIDE + dt * 64), hi = tr_read(vb + (64 * kt + 16 * kv + 8) * SBV_STRIDE + dt * 64);
                o[dt] = MFMA32(pa[kv], cat8(lo, hi), o[dt]);
            }
    }
    psum += __shfl_xor(psum, 32);
    if (h == 0) scr[c] = 1.f / psum;
    asm volatile("s_waitcnt lgkmcnt(0)" ::: "memory");
    float rinv[16];
#pragma unroll
    for (int r = 0; r < 16; ++r) { const float il = scr[crow(r, h)];
        o[0][r] *= il; o[1][r] *= il; o[2][r] *= il; o[3][r] *= il;
        float ss = o[0][r] * o[0][r] + o[1][r] * o[1][r] + o[2][r] * o[2][r] + o[3][r] * o[3][r];
        ss += __shfl_xor(ss, 1); ss += __shfl_xor(ss, 2); ss += __shfl_xor(ss, 4); ss += __shfl_xor(ss, 8); ss += __shfl_xor(ss, 16);
        rinv[r] = rsqrtf(ss * (1.f / HD) + RMS_EPS); }
#pragma unroll
    for (int dt = 0; dt < 4; ++dt) { const float nw = mem_norm_w[hh * 128 + 32 * dt + c];
#pragma unroll
        for (int r = 0; r < 16; ++r) OMIX[(row0 + crow(r, h)) * D + 1536 + hh * 128 + 32 * dt + c] = (bf16)f2bf(o[dt][r] * rinv[r] * nw); }
}

struct Epi2 {
    static constexpr bool PERM = true, AFTER_DRAIN = false;
    const bf16* H; bf16* Y;
    __device__ __forceinline__ void operator()(const pg8::f32x4 (&acc)[2][2][4][2], const pg8::Unit& u, int wr, int wc, int fr, int fq) const {
        const int row0 = u.pm * 256 + wr * 64 + fr, col0 = u.pn * 256 + wc * 32 + 8 * fq;
#pragma unroll
        for (int ai = 0; ai < 2; ++ai)
#pragma unroll
            for (int m = 0; m < 4; ++m) { const size_t off = (size_t)(row0 + ai * 128 + m * 16) * D + col0;
#pragma unroll
                for (int bj = 0; bj < 2; ++bj) { const v4u h4 = *(const v4u*)(H + off + bj * 128);
                    const pg8::f32x4 v0 = acc[ai][bj][m][0], v1 = acc[ai][bj][m][1];
                    v4u w; w.x = pk2(v0[0] + ALPHA * bflo(h4.x), v0[1] + ALPHA * bfhi(h4.x)); w.y = pk2(v0[2] + ALPHA * bflo(h4.y), v0[3] + ALPHA * bfhi(h4.y));
                    w.z = pk2(v1[0] + ALPHA * bflo(h4.z), v1[1] + ALPHA * bfhi(h4.z)); w.w = pk2(v1[2] + ALPHA * bflo(h4.w), v1[3] + ALPHA * bfhi(h4.w));
                    *(v4u*)(Y + off + bj * 128) = w; } }
    }
};
struct Epi3 {
    static constexpr bool PERM = true, AFTER_DRAIN = false;
    bf16* O;
    __device__ __forceinline__ void operator()(const pg8::f32x4 (&acc)[2][2][4][2], const pg8::Unit& u, int wr, int wc, int fr, int fq) const {
        const int row0 = u.pm * 256 + wr * 64 + fr, col0 = u.pn * 256 + wc * 32 + 8 * fq;
#pragma unroll
        for (int ai = 0; ai < 2; ++ai)
#pragma unroll
            for (int m = 0; m < 4; ++m) { bf16* rowp = O + (size_t)(row0 + ai * 128 + m * 16) * D + col0;
#pragma unroll
                for (int bj = 0; bj < 2; ++bj) { const pg8::f32x4 v0 = acc[ai][bj][m][0], v1 = acc[ai][bj][m][1];
                    pg8::u32x4 w; w.x = pg8::cvt_pk_bf16(v0[0], v0[1]); w.y = pg8::cvt_pk_bf16(v0[2], v0[3]); w.z = pg8::cvt_pk_bf16(v1[0], v1[1]); w.w = pg8::cvt_pk_bf16(v1[2], v1[3]);
                    *(pg8::u32x4*)(rowp + bj * 128) = w; } }
    }
};

__device__ __forceinline__ void p5_ln1_tables(Frame& F, const float* l1w, const float* l1b, const float* pu, const float* pv) {
    const int lane_ = fresh_lane(), tid_ = F.wave * 64 + lane_; (void)tid_;
    const int gw = F.vcu * NWAVES + F.wave, NGW = F.G * NWAVES;
    const bf16* Y1 = (const bf16*)(F.ws + WS_Y1); bf16* XN2 = (bf16*)(F.ws + WS_XN);
    unsigned char* XQ = F.ws + WS_XQ; float* XST = (float*)(F.ws + WS_XSTEP);
    for (int m = gw; m < M; m += 2 * NGW) ln_rows2_bf16in(Y1 + (size_t)m * D, Y1 + (size_t)(m + NGW) * D, l1w, l1b, XN2 + (size_t)m * D, XN2 + (size_t)(m + NGW) * D,
                                                          XQ + (size_t)m * D, XQ + (size_t)(m + NGW) * D, XST + (size_t)m * 8, XST + (size_t)(m + NGW) * 8, lane_);
}

__device__ __forceinline__ void peer_tables_convert(Frame& F, const float* pu, const float* pv, const int gwt, const int ngwt, const int slot) {
    const int lane_ = fresh_lane(); const int gw = gwt, NGW = ngwt;
    float smx[8];
#pragma unroll
    for (int j = 0; j < 8; ++j) smx[j] = 0.f;
    for (int r2 = gw; r2 < 2 * PE_NEXP; r2 += NGW) {
        const int tsel = r2 >= PE_NEXP, e = r2 - tsel * PE_NEXP;
        const f32x4* src = (const f32x4*)((tsel ? pv : pu) + (size_t)e * D) + lane_;
        unsigned char* trow = F.ws + (tsel ? WS_VT : WS_UT) + (size_t)e * UROW;
        f32x4 v[8];
#pragma unroll
        for (int j = 0; j < 8; ++j) v[j] = src[64 * j];
        const int ob = tsel ? 8 : 0;
#pragma unroll
        for (int j = 0; j < 8; ++j) {
            float am = fmaxf(fmaxf(fabsf(v[j].x), fabsf(v[j].y)), fmaxf(fabsf(v[j].z), fabsf(v[j].w)));
            am = fmaxf(am, __shfl_xor(am, 1)); am = fmaxf(am, __shfl_xor(am, 2)); am = fmaxf(am, __shfl_xor(am, 4));
            const float inv = am > 0.f ? 7.f / am : 0.f;
            const unsigned mine = (unsigned)(((int)rintf(v[j].x * inv) + ob) & 15) | ((unsigned)(((int)rintf(v[j].y * inv) + ob) & 15) << 8)
                                | ((unsigned)(((int)rintf(v[j].z * inv) + ob) & 15) << 16) | ((unsigned)(((int)rintf(v[j].w * inv) + ob) & 15) << 24);
            const unsigned other = (unsigned)__shfl_xor((int)mine, 1);
            if (tsel) {
                if ((lane_ & 1) == 0) *(unsigned*)(trow + 4 * ((lane_ >> 1) + 32 * j)) = mine | (other << 4);
                if ((lane_ & 7) == 0) *(bf16*)(trow + 1024 + 2 * ((lane_ >> 3) + 8 * j)) = (bf16)f2bf(am * (1.f / 7.f));
            } else {
                if ((lane_ & 1) == 0) *(unsigned*)(F.ws + WS_UT + (size_t)j * UT_SLICE + (size_t)e * 128 + 4 * (lane_ >> 1)) = mine | (other << 4);
                const bf16 stp = (bf16)f2bf(am * (1.f / 7.f));
                if ((lane_ & 7) == 0) *(bf16*)(F.ws + WS_UT + US_OFF + (size_t)j * US_SLICE + (size_t)e * 16 + 2 * (lane_ >> 3)) = stp;
                smx[j] = fmaxf(smx[j], bf2f(stp));
            }
        }
    }
    float* SMW = (float*)(F.ws + WS_SMW) + (size_t)slot * 8;
#pragma unroll
    for (int j = 0; j < 8; ++j) { const float m = wave_max(smx[j]); if (lane_ == 0) SMW[j] = m; }
}


__device__ __forceinline__ float partner32(float y, int h) { const auto rr = __builtin_amdgcn_permlane32_swap(__float_as_uint(y), __float_as_uint(y), false, false); return __uint_as_float(h ? rr[0] : rr[1]); }
__device__ __forceinline__ float max3f(float a, float b, float c) { return fmaxf(fmaxf(a, b), c); }
template <int N> __device__ __forceinline__ float maxN(const float (&v)[N]) {
    float m[(N + 2) / 3];
#pragma unroll
    for (int i = 0; i < (N + 2) / 3; ++i) { const float a = v[3 * i], b = (3 * i + 1 < N) ? v[3 * i + 1] : a, c = (3 * i + 2 < N) ? v[3 * i + 2] : a; m[i] = max3f(a, b, c); }
    if constexpr ((N + 2) / 3 == 1) return m[0]; else return maxN<(N + 2) / 3>(m);
}
template <int N> __device__ __forceinline__ void top16_regs(float (&v)[N], float (&top)[16]) {
#pragma unroll
    for (int r = 0; r < 16; ++r) { const float m = maxN<N>(v); top[r] = m;
#pragma unroll
        for (int i = 0; i < N; ++i) v[i] = (v[i] == m) ? -INFINITY : v[i]; }
}
__device__ __forceinline__ void merge_partner(const float (&own)[16], float (&t)[16], int h) {
#pragma unroll
    for (int i = 0; i < 16; ++i) t[i] = fmaxf(own[i], partner32(own[15 - i], h));
}
__device__ __forceinline__ void sort16_desc(float (&t)[16]) {
#pragma unroll
    for (int k = 2; k <= 16; k <<= 1)
#pragma unroll
        for (int j = k >> 1; j > 0; j >>= 1)
#pragma unroll
            for (int i = 0; i < 16; ++i) { const int l = i ^ j; if (l > i) { const float a = t[i], b = t[l]; const float mx = fmaxf(a, b), mn = fminf(a, b); if ((i & k) == 0) { t[i] = mx; t[l] = mn; } else { t[i] = mn; t[l] = mx; } } }
}
__device__ __forceinline__ void merge16_desc(float (&t)[16]) {
#pragma unroll
    for (int j = 8; j > 0; j >>= 1)
#pragma unroll
        for (int i = 0; i < 16; ++i) if ((i & j) == 0) { const float a = t[i], b = t[i + j]; t[i] = fmaxf(a, b); t[i + j] = fminf(a, b); }
}
__device__ __forceinline__ void peer_half_top16(const LAS unsigned char* Kh, const bf16* qh, int c, int h, float (&out)[16]) {
    bf16x8 qf[8];
#pragma unroll
    for (int ks = 0; ks < 8; ++ks) qf[ks] = *(const bf16x8*)(qh + 16 * ks + 8 * h);
    float sv[64];
#pragma unroll
    for (int rt = 0; rt < 4; ++rt) {
        f32x16 acc;
#pragma unroll
        for (int r = 0; r < 16; ++r) acc[r] = 0.f;
#pragma unroll
        for (int ks = 0; ks < 8; ++ks) acc = MFMA32(*(const LAS bf16x8*)(Kh + (32 * rt + c) * MK_STRIDE + (16 * ks + 8 * h) * 2), qf[ks], acc);
#pragma unroll
        for (int r = 0; r < 16; ++r) sv[rt * 16 + r] = __uint_as_float((__float_as_uint(acc[r]) & ~0x7Fu) | (unsigned)(32 * rt + (r & 3) + 8 * (r >> 2)) | ((unsigned)h << 2));
    }
    float g0[16], g1[16], g2[16], g3[16];
#pragma unroll
    for (int i = 0; i < 16; ++i) { g0[i] = sv[i]; g1[i] = sv[16 + i]; g2[i] = sv[32 + i]; g3[i] = sv[48 + i]; }
    sort16_desc(g0); sort16_desc(g1); sort16_desc(g2); sort16_desc(g3);
    float m01[16], m23[16], top[16];
#pragma unroll
    for (int i = 0; i < 16; ++i) { m01[i] = fmaxf(g0[i], g1[15 - i]); m23[i] = fmaxf(g2[i], g3[15 - i]); }
    merge16_desc(m01); merge16_desc(m23);
#pragma unroll
    for (int i = 0; i < 16; ++i) top[i] = fmaxf(m01[i], m23[15 - i]);
    merge16_desc(top);
    merge_partner(top, out, h);
    merge16_desc(out);
}
__device__ __forceinline__ void p7_peer_scores(Frame& F, const float* keys1, const float* keys2) {
    const int lane = fresh_lane(), tid = F.wave * 64 + lane, c = lane & 31, h = lane >> 5;
    LAS unsigned char* K1 = F.lds; LAS unsigned char* K2 = F.lds + 128 * MK_STRIDE;
    __syncthreads();
    for (int i = tid; i < 2 * 128 * 16; i += NTHREADS) { const int which = i >> 11, r = (i >> 4) & 127, ch = i & 15;
        const float* src = (which ? keys2 : keys1) + r * 128 + 8 * ch; const f32x4 a = *(const f32x4*)src, b = *(const f32x4*)(src + 4);
        v4u o; o.x = pk2(a.x, a.y); o.y = pk2(a.z, a.w); o.z = pk2(b.x, b.y); o.w = pk2(b.z, b.w);
        *(LAS v4u*)((which ? K2 : K1) + r * MK_STRIDE + 16 * ch) = o; }
    __syncthreads();
    const bf16* Q = (const bf16*)(F.ws + WS_Q); int* IDX = (int*)(F.ws + WS_IDX); float* GATE = (float*)(F.ws + WS_GATE);
    const int gw = F.vcu * NWAVES + F.wave, NGW = F.G * NWAVES;
    for (int item = gw; item < (M / 32) * PE_HEADS; item += NGW) {
        const int tt = item >> 3, hd = item & 7; const size_t token = (size_t)tt * 32 + c;
        const bf16* qrow = Q + token * D + hd * 256;
        float v1[16], v2[16];
        peer_half_top16(K1, qrow, c, h, v1);
        peer_half_top16(K2, qrow + 128, c, h, v2);
        const int hq = fresh_lane() >> 5;
        float cs[25]; int cp[25];
        { const float x1 = hq ? v1[0] : v1[0], x2 = hq ? v2[1] : v2[0]; cs[0] = __uint_as_float((__float_as_uint(x1 + x2) & ~0x3Fu) | (unsigned)(0) | ((unsigned)hq << 5)); cp[0] = (int)(((__float_as_uint(x1) & 0x7Fu) << 7) | (__float_as_uint(x2) & 0x7Fu)); }
        { const float x1 = hq ? v1[0] : v1[0], x2 = hq ? v2[3] : v2[2]; cs[1] = __uint_as_float((__float_as_uint(x1 + x2) & ~0x3Fu) | (unsigned)(1) | ((unsigned)hq << 5)); cp[1] = (int)(((__float_as_uint(x1) & 0x7Fu) << 7) | (__float_as_uint(x2) & 0x7Fu)); }
        { const float x1 = hq ? v1[0] : v1[0], x2 = hq ? v2[5] : v2[4]; cs[2] = __uint_as_float((__float_as_uint(x1 + x2) & ~0x3Fu) | (unsigned)(2) | ((unsigned)hq << 5)); cp[2] = (int)(((__float_as_uint(x1) & 0x7Fu) << 7) | (__float_as_uint(x2) & 0x7Fu)); }
        { const float x1 = hq ? v1[0] : v1[0], x2 = hq ? v2[7] : v2[6]; cs[3] = __uint_as_float((__float_as_uint(x1 + x2) & ~0x3Fu) | (unsigned)(3) | ((unsigned)hq << 5)); cp[3] = (int)(((__float_as_uint(x1) & 0x7Fu) << 7) | (__float_as_uint(x2) & 0x7Fu)); }
        { const float x1 = hq ? v1[0] : v1[0], x2 = hq ? v2[9] : v2[8]; cs[4] = __uint_as_float((__float_as_uint(x1 + x2) & ~0x3Fu) | (unsigned)(4) | ((unsigned)hq << 5)); cp[4] = (int)(((__float_as_uint(x1) & 0x7Fu) << 7) | (__float_as_uint(x2) & 0x7Fu)); }
        { const float x1 = hq ? v1[0] : v1[0], x2 = hq ? v2[11] : v2[10]; cs[5] = __uint_as_float((__float_as_uint(x1 + x2) & ~0x3Fu) | (unsigned)(5) | ((unsigned)hq << 5)); cp[5] = (int)(((__float_as_uint(x1) & 0x7Fu) << 7) | (__float_as_uint(x2) & 0x7Fu)); }
        { const float x1 = hq ? v1[0] : v1[0], x2 = hq ? v2[13] : v2[12]; cs[6] = __uint_as_float((__float_as_uint(x1 + x2) & ~0x3Fu) | (unsigned)(6) | ((unsigned)hq << 5)); cp[6] = (int)(((__float_as_uint(x1) & 0x7Fu) << 7) | (__float_as_uint(x2) & 0x7Fu)); }
        { const float x1 = hq ? v1[0] : v1[0], x2 = hq ? v2[15] : v2[14]; cs[7] = __uint_as_float((__float_as_uint(x1 + x2) & ~0x3Fu) | (unsigned)(7) | ((unsigned)hq << 5)); cp[7] = (int)(((__float_as_uint(x1) & 0x7Fu) << 7) | (__float_as_uint(x2) & 0x7Fu)); }
        { const float x1 = hq ? v1[1] : v1[1], x2 = hq ? v2[1] : v2[0]; cs[8] = __uint_as_float((__float_as_uint(x1 + x2) & ~0x3Fu) | (unsigned)(8) | ((unsigned)hq << 5)); cp[8] = (int)(((__float_as_uint(x1) & 0x7Fu) << 7) | (__float_as_uint(x2) & 0x7Fu)); }
        { const float x1 = hq ? v1[1] : v1[1], x2 = hq ? v2[3] : v2[2]; cs[9] = __uint_as_float((__float_as_uint(x1 + x2) & ~0x3Fu) | (unsigned)(9) | ((unsigned)hq << 5)); cp[9] = (int)(((__float_as_uint(x1) & 0x7Fu) << 7) | (__float_as_uint(x2) & 0x7Fu)); }
        { const float x1 = hq ? v1[1] : v1[1], x2 = hq ? v2[5] : v2[4]; cs[10] = __uint_as_float((__float_as_uint(x1 + x2) & ~0x3Fu) | (unsigned)(10) | ((unsigned)hq << 5)); cp[10] = (int)(((__float_as_uint(x1) & 0x7Fu) << 7) | (__float_as_uint(x2) & 0x7Fu)); }
        { const float x1 = hq ? v1[1] : v1[1], x2 = hq ? v2[7] : v2[6]; cs[11] = __uint_as_float((__float_as_uint(x1 + x2) & ~0x3Fu) | (unsigned)(11) | ((unsigned)hq << 5)); cp[11] = (int)(((__float_as_uint(x1) & 0x7Fu) << 7) | (__float_as_uint(x2) & 0x7Fu)); }
        { const float x1 = hq ? v1[2] : v1[2], x2 = hq ? v2[1] : v2[0]; cs[12] = __uint_as_float((__float_as_uint(x1 + x2) & ~0x3Fu) | (unsigned)(12) | ((unsigned)hq << 5)); cp[12] = (int)(((__float_as_uint(x1) & 0x7Fu) << 7) | (__float_as_uint(x2) & 0x7Fu)); }
        { const float x1 = hq ? v1[2] : v1[2], x2 = hq ? v2[3] : v2[2]; cs[13] = __uint_as_float((__float_as_uint(x1 + x2) & ~0x3Fu) | (unsigned)(13) | ((unsigned)hq << 5)); cp[13] = (int)(((__float_as_uint(x1) & 0x7Fu) << 7) | (__float_as_uint(x2) & 0x7Fu)); }
        { const float x1 = hq ? v1[3] : v1[2], x2 = hq ? v2[0] : v2[4]; cs[14] = __uint_as_float((__float_as_uint(x1 + x2) & ~0x3Fu) | (unsigned)(14) | ((unsigned)hq << 5)); cp[14] = (int)(((__float_as_uint(x1) & 0x7Fu) << 7) | (__float_as_uint(x2) & 0x7Fu)); }
        { const float x1 = hq ? v1[3] : v1[3], x2 = hq ? v2[2] : v2[1]; cs[15] = __uint_as_float((__float_as_uint(x1 + x2) & ~0x3Fu) | (unsigned)(15) | ((unsigned)hq << 5)); cp[15] = (int)(((__float_as_uint(x1) & 0x7Fu) << 7) | (__float_as_uint(x2) & 0x7Fu)); }
        { const float x1 = hq ? v1[4] : v1[3], x2 = hq ? v2[0] : v2[3]; cs[16] = __uint_as_float((__float_as_uint(x1 + x2) & ~0x3Fu) | (unsigned)(16) | ((unsigned)hq << 5)); cp[16] = (int)(((__float_as_uint(x1) & 0x7Fu) << 7) | (__float_as_uint(x2) & 0x7Fu)); }
        { const float x1 = hq ? v1[4] : v1[4], x2 = hq ? v2[2] : v2[1]; cs[17] = __uint_as_float((__float_as_uint(x1 + x2) & ~0x3Fu) | (unsigned)(17) | ((unsigned)hq << 5)); cp[17] = (int)(((__float_as_uint(x1) & 0x7Fu) << 7) | (__float_as_uint(x2) & 0x7Fu)); }
        { const float x1 = hq ? v1[5] : v1[5], x2 = hq ? v2[1] : v2[0]; cs[18] = __uint_as_float((__float_as_uint(x1 + x2) & ~0x3Fu) | (unsigned)(18) | ((unsigned)hq << 5)); cp[18] = (int)(((__float_as_uint(x1) & 0x7Fu) << 7) | (__float_as_uint(x2) & 0x7Fu)); }
        { const float x1 = hq ? v1[6] : v1[6], x2 = hq ? v2[1] : v2[0]; cs[19] = __uint_as_float((__float_as_uint(x1 + x2) & ~0x3Fu) | (unsigned)(19) | ((unsigned)hq << 5)); cp[19] = (int)(((__float_as_uint(x1) & 0x7Fu) << 7) | (__float_as_uint(x2) & 0x7Fu)); }
        { const float x1 = hq ? v1[7] : v1[7], x2 = hq ? v2[1] : v2[0]; cs[20] = __uint_as_float((__float_as_uint(x1 + x2) & ~0x3Fu) | (unsigned)(20) | ((unsigned)hq << 5)); cp[20] = (int)(((__float_as_uint(x1) & 0x7Fu) << 7) | (__float_as_uint(x2) & 0x7Fu)); }
        { const float x1 = hq ? v1[9] : v1[8], x2 = hq ? v2[0] : v2[0]; cs[21] = __uint_as_float((__float_as_uint(x1 + x2) & ~0x3Fu) | (unsigned)(21) | ((unsigned)hq << 5)); cp[21] = (int)(((__float_as_uint(x1) & 0x7Fu) << 7) | (__float_as_uint(x2) & 0x7Fu)); }
        { const float x1 = hq ? v1[11] : v1[10], x2 = hq ? v2[0] : v2[0]; cs[22] = __uint_as_float((__float_as_uint(x1 + x2) & ~0x3Fu) | (unsigned)(22) | ((unsigned)hq << 5)); cp[22] = (int)(((__float_as_uint(x1) & 0x7Fu) << 7) | (__float_as_uint(x2) & 0x7Fu)); }
        { const float x1 = hq ? v1[13] : v1[12], x2 = hq ? v2[0] : v2[0]; cs[23] = __uint_as_float((__float_as_uint(x1 + x2) & ~0x3Fu) | (unsigned)(23) | ((unsigned)hq << 5)); cp[23] = (int)(((__float_as_uint(x1) & 0x7Fu) << 7) | (__float_as_uint(x2) & 0x7Fu)); }
        { const float x1 = hq ? v1[15] : v1[14], x2 = hq ? v2[0] : v2[0]; cs[24] = __uint_as_float((__float_as_uint(x1 + x2) & ~0x3Fu) | (unsigned)(24) | ((unsigned)hq << 5)); cp[24] = (int)(((__float_as_uint(x1) & 0x7Fu) << 7) | (__float_as_uint(x2) & 0x7Fu)); }
        float ctop[16], ft[16]; int ctp[16], fp[16];
#pragma unroll
        for (int r = 0; r < 16; ++r) { const float m = maxN<25>(cs); ctop[r] = m; int p = 0;
#pragma unroll
            for (int i = 0; i < 25; ++i) { const bool eq = (cs[i] == m); p = eq ? cp[i] : p; cs[i] = eq ? -INFINITY : cs[i]; }
            ctp[r] = p; }
#pragma unroll
        for (int i = 0; i < 16; ++i) { const float py = partner32(ctop[15 - i], h); const int pp = (int)__float_as_uint(partner32(__uint_as_float((unsigned)ctp[15 - i]), h));
            ft[i] = fmaxf(ctop[i], py); fp[i] = (ctop[i] >= py) ? ctp[i] : pp; }
        const float mx = maxN<16>(ft); float e[16], sum = 0.f;
#pragma unroll
        for (int i = 0; i < 16; ++i) { e[i] = __expf(ft[i] - mx); sum += e[i]; }
        const float inv = 1.f / sum;
        int idx8[8]; float g8[8];
#pragma unroll
        for (int i = 0; i < 8; ++i) { idx8[i] = fp[i]; g8[i] = e[i] * inv; }
        int* ip = IDX + token * PE_SEL + hd * 16 + 8 * h; float* gp = GATE + token * PE_SEL + hd * 16 + 8 * h;
        *(v4u*)ip = (v4u){(unsigned)idx8[0], (unsigned)idx8[1], (unsigned)idx8[2], (unsigned)idx8[3]}; *(v4u*)(ip + 4) = (v4u){(unsigned)idx8[4], (unsigned)idx8[5], (unsigned)idx8[6], (unsigned)idx8[7]};
        *(f32x4*)gp = (f32x4){g8[0], g8[1], g8[2], g8[3]}; *(f32x4*)(gp + 4) = (f32x4){g8[4], g8[5], g8[6], g8[7]};
    }
}

__device__ __forceinline__ float gelu_exact(float x) { return 0.5f * x * (1.f + erff(x * 0.7071067811865476f)); }
__device__ __forceinline__ float ub0(unsigned w) { float f; asm("v_cvt_f32_ubyte0_e32 %0, %1" : "=v"(f) : "v"(w)); return f; }
__device__ __forceinline__ float ub1(unsigned w) { float f; asm("v_cvt_f32_ubyte1_e32 %0, %1" : "=v"(f) : "v"(w)); return f; }
__device__ __forceinline__ float ub2(unsigned w) { float f; asm("v_cvt_f32_ubyte2_e32 %0, %1" : "=v"(f) : "v"(w)); return f; }
__device__ __forceinline__ float ub3(unsigned w) { float f; asm("v_cvt_f32_ubyte3_e32 %0, %1" : "=v"(f) : "v"(w)); return f; }
typedef int v4i_t __attribute__((ext_vector_type(4)));
#define DPP_ADD(v, ctrl) ((v) + __uint_as_float((unsigned)__builtin_amdgcn_update_dpp(0, (int)__float_as_uint(v), (ctrl), 0xF, 0xF, true)))
__device__ __forceinline__ void p8a_peer_u(Frame& F) {
    const int lane = fresh_lane(); const int c = lane & 7, jg = lane >> 3;
    const int x = (int)blockIdx.x & 7, nr = (F.G - x + 7) >> 3, rank = (int)blockIdx.x >> 3;
    const int w0 = rank * NWAVES + F.wave, nw = nr * NWAVES;
    const unsigned char* UTx = F.ws + WS_UT + (size_t)x * UT_SLICE + 16 * c; const unsigned char* USx = F.ws + WS_UT + US_OFF + (size_t)x * US_SLICE + 2 * c;
    const int* IDX = (const int*)(F.ws + WS_IDX) + 16 * jg; const unsigned char* XQ = F.ws + WS_XQ + 128 * x + 16 * c; const float* XST = (const float*)(F.ws + WS_XSTEP) + x;
    float* PART = (float*)(F.ws + WS_PART) + (size_t)x * M * PE_SEL + 16 * jg;
    float smax;
    {
        const int tid_ = F.wave * 64 + lane; const int nslots = (F.G - BATCH * GH) * NWAVES;
        const float* SMW = (const float*)(F.ws + WS_SMW) + x; float m = 0.f;
        for (int i = tid_; i < nslots; i += NTHREADS) m = fmaxf(m, SMW[(size_t)i * 8]);
        m = wave_max(m);
        __syncthreads();
        if (lane == 0) *(LAS float*)(F.lds + 4 * F.wave) = m;
        __syncthreads();
        smax = 0.f;
#pragma unroll
        for (int w = 0; w < NWAVES; ++w) smax = fmaxf(smax, *(const LAS float*)(F.lds + 4 * w));
        const float sinv = smax > 0.f ? 255.f / smax : 0.f;
        __syncthreads();
#pragma unroll 8
        for (int r = tid_; r < PE_NEXP; r += NTHREADS) { const v4u sv = *(const v4u*)(USx - 2 * c + (size_t)r * 16); v2u o;
            o.x = (unsigned)fminf(rintf(bflo(sv.x) * sinv), 255.f) | ((unsigned)fminf(rintf(bfhi(sv.x) * sinv), 255.f) << 8) | ((unsigned)fminf(rintf(bflo(sv.y) * sinv), 255.f) << 16) | ((unsigned)fminf(rintf(bfhi(sv.y) * sinv), 255.f) << 24);
            o.y = (unsigned)fminf(rintf(bflo(sv.z) * sinv), 255.f) | ((unsigned)fminf(rintf(bfhi(sv.z) * sinv), 255.f) << 8) | ((unsigned)fminf(rintf(bflo(sv.w) * sinv), 255.f) << 16) | ((unsigned)fminf(rintf(bfhi(sv.w) * sinv), 255.f) << 24);
            *(LAS v2u*)(F.lds + 8 * r) = o; }
        __syncthreads();
    }
    const float sunit = smax * (1.f / 255.f);
#define P8A_LOADTOK(tt, E, XA, XB, XS) do { const int t_ = (tt) < M ? (tt) : M - 1; _Pragma("unroll") for (int q = 0; q < 4; ++q) E[q] = *(const v4i_t*)(IDX + (size_t)t_ * PE_SEL + 4 * q); \
        XA = *(const v4u*)(XQ + (size_t)t_ * D); XB = *(const v4u*)(XQ + (size_t)t_ * D + 1024); XS = XST[(size_t)t_ * 8]; } while (0)
#define P8A_ROW(slot, e_) do { const int e__ = (e_); a[slot] = *(const v4u*)(UTx + (size_t)e__ * 128); } while (0)
    v4i_t ec[4], en[4], e2[4]; v4u xac, xbc, xan, xbn, xa2, xb2; float xsc, xsn, xs2;
    P8A_LOADTOK(w0, ec, xac, xbc, xsc); P8A_LOADTOK(w0 + nw, en, xan, xbn, xsn);
    v4u a[16];
#ifndef P8A_DIST
#define P8A_DIST 8
#endif
#pragma unroll
    for (int i = 0; i < P8A_DIST; ++i) P8A_ROW(i, ec[i >> 2][i & 3]);
    for (int t = w0; t < M; t += nw) {
        P8A_LOADTOK(t + 2 * nw, e2, xa2, xb2, xs2);
        asm volatile("" ::: "memory");
        unsigned char gs[16];
#pragma unroll
        for (int i = 0; i < 16; ++i) gs[i] = *(const LAS unsigned char*)(F.lds + 8 * ec[i >> 2][i & 3] + c);
        const float xsu = xsc * sunit;
        float sf[16];
#pragma unroll
        for (int i = 0; i < 16; ++i) {
            if (i + P8A_DIST < 16) P8A_ROW(i + P8A_DIST, ec[(i + P8A_DIST) >> 2][(i + P8A_DIST) & 3]); else P8A_ROW(i + P8A_DIST - 16, en[(i + P8A_DIST - 16) >> 2][(i + P8A_DIST - 16) & 3]);
            asm volatile("" ::: "memory");
            int sh_ = 0, sl_ = 0;
#pragma unroll
            for (int d4 = 0; d4 < 4; ++d4) { sh_ = __builtin_amdgcn_sdot8((int)a[i][d4], (int)xac[d4], sh_, false); sl_ = __builtin_amdgcn_sdot8((int)a[i][d4], (int)xbc[d4], sl_, false); }
            const int sdt = (sh_ << 4) + sl_;
            float v = (float)sdt * (float)gs[i];
            v = DPP_ADD(v, 0xB1); v = DPP_ADD(v, 0x4E); v = DPP_ADD(v, 0x141);
            sf[i] = v * xsu;
        }
        if (c == 0) {
#pragma unroll
            for (int q = 0; q < 4; ++q) { f32x4 o; o.x = sf[4 * q]; o.y = sf[4 * q + 1]; o.z = sf[4 * q + 2]; o.w = sf[4 * q + 3]; *(f32x4*)(PART + (size_t)t * PE_SEL + 4 * q) = o; }
        }
#pragma unroll
        for (int q = 0; q < 4; ++q) { ec[q] = en[q]; en[q] = e2[q]; }
        xac = xan; xbc = xbn; xsc = xsn; xan = xa2; xbn = xb2; xsn = xs2;
    }
#undef P8A_LOADTOK
#undef P8A_ROW
}
__device__ __forceinline__ void p8_peer_experts(Frame& F, const float* l2w, const float* l2b) {
    const int lane = fresh_lane(); const int gw = F.vcu * NWAVES + F.wave, NGW = F.G * NWAVES;
    const bf16* XN2 = (const bf16*)(F.ws + WS_XN); const unsigned char* U8 = F.ws + WS_UT; const unsigned char* V8 = F.ws + WS_VT;
    const float* USTEP = (const float*)(F.ws + WS_USTEP); const float* VSTEP = (const float*)(F.ws + WS_VSTEP);
    const int* IDX = (const int*)(F.ws + WS_IDX); const float* GATE = (const float*)(F.ws + WS_GATE); const float* PART = (const float*)(F.ws + WS_PART);
    for (int row = gw; row < M; row += NGW) {
        float x[32], acc[32];
#pragma unroll
        for (int q = 0; q < 4; ++q) { const v4u xv = *(const v4u*)(XN2 + (size_t)row * D + 32 * lane + 8 * q);
            float* xp = x + 8 * q; xp[0] = bflo(xv.x); xp[1] = bfhi(xv.x); xp[2] = bflo(xv.y); xp[3] = bfhi(xv.y); xp[4] = bflo(xv.z); xp[5] = bfhi(xv.z); xp[6] = bflo(xv.w); xp[7] = bfhi(xv.w); }
#pragma unroll
        for (int i = 0; i < 32; ++i) acc[i] = 0.f;
        float wtot = 0.f;
        const int my_e0 = IDX[(size_t)row * PE_SEL + lane], my_e1 = IDX[(size_t)row * PE_SEL + 64 + lane];
        float my_w0, my_w1;
        { const float g0 = GATE[(size_t)row * PE_SEL + lane], g1 = GATE[(size_t)row * PE_SEL + 64 + lane]; float d0 = 0.f, d1 = 0.f;
#pragma unroll
          for (int xs_ = 0; xs_ < 8; ++xs_) { d0 += PART[(size_t)xs_ * M * PE_SEL + (size_t)row * PE_SEL + lane]; d1 += PART[(size_t)xs_ * M * PE_SEL + (size_t)row * PE_SEL + 64 + lane]; }
          my_w0 = g0 * gelu_exact(d0); my_w1 = g1 * gelu_exact(d1); }
        v4u a[8]; bf16 gs[8];
#define P8V_ROW(slot, e_) do { const unsigned char* vp__ = V8 + (size_t)(e_) * UROW; a[slot] = *(const v4u*)(vp__ + 16 * lane); gs[slot] = *(const bf16*)(vp__ + 1024 + 2 * lane); } while (0)
#pragma unroll
        for (int i = 0; i < 4; ++i) P8V_ROW(i, __builtin_amdgcn_readlane(my_e0, i));
        for (int q = 0; q < 16; ++q) {
            const int my_e = q < 8 ? my_e0 : my_e1; const float my_w = q < 8 ? my_w0 : my_w1;
            const int my_en = q < 7 ? my_e0 : my_e1;
#pragma unroll
            for (int i = 0; i < 8; ++i) {
                { const int kp = 8 * q + i + 4; const int kc = kp < 128 ? kp : 127;
                  const int ep = (i < 4) ? __builtin_amdgcn_readlane(my_e, kc & 63) : __builtin_amdgcn_readlane(my_en, kc & 63);
                  P8V_ROW((i + 4) & 7, ep); }
                asm volatile("" ::: "memory");
                const float w0 = __uint_as_float((unsigned)__builtin_amdgcn_readlane((int)__float_as_uint(my_w), (8 * q + i) & 63));
                const float w = w0 * bf2f(gs[i]);
                wtot += w; const float w16 = w * 0.0625f;
#pragma unroll
                for (int d4 = 0; d4 < 4; ++d4) { const unsigned lo = a[i][d4] & 0x0F0F0F0Fu, by = a[i][d4];
                    acc[8 * d4] += w * ub0(lo); acc[8 * d4 + 1] += w * ub1(lo); acc[8 * d4 + 2] += w * ub2(lo); acc[8 * d4 + 3] += w * ub3(lo);
                    acc[8 * d4 + 4] += w16 * ub0(by); acc[8 * d4 + 5] += w16 * ub1(by); acc[8 * d4 + 6] += w16 * ub2(by); acc[8 * d4 + 7] += w16 * ub3(by); }
            }
        }
#undef P8V_ROW
        float s_ = 0.f;
#pragma unroll
        for (int d4 = 0; d4 < 4; ++d4)
#pragma unroll
            for (int b = 0; b < 4; ++b) acc[8 * d4 + 4 + b] -= 0.0625f * acc[8 * d4 + b];
#pragma unroll
        for (int i = 0; i < 32; ++i) { acc[i] = acc[i] - 8.f * wtot + ALPHA * x[i]; s_ += acc[i]; }
        const float mean = wave_sum(s_) * (1.f / D); float s2 = 0.f;
#pragma unroll
        for (int i = 0; i < 32; ++i) { acc[i] -= mean; s2 += acc[i] * acc[i]; }
        const float rstd = 1.f / sqrtf(wave_sum(s2) * (1.f / D) + LN_EPS);
#pragma unroll
        for (int q = 0; q < 8; ++q) {
            const int col = 32 * lane + 4 * q;
            const f32x4 w4 = *(const f32x4*)(l2w + col), b4 = *(const f32x4*)(l2b + col);
            f32x4 r; r.x = acc[4 * q] * rstd * w4.x + b4.x; r.y = acc[4 * q + 1] * rstd * w4.y + b4.y; r.z = acc[4 * q + 2] * rstd * w4.z + b4.z; r.w = acc[4 * q + 3] * rstd * w4.w + b4.w;
            *(f32x4*)(F.out + (size_t)row * D + col) = r;
        }
    }
}

constexpr int CW_BAR = 4096;
constexpr int LDS_BARST_OFF = LDS_BYTES - 64;
#define XB_TMO      128
#define XB_XCNT(j)  (256  + 64 * (j))
#define XB_XSUB(j)  (1280 + 64 * (j))
#define XB_XGEN(j)  (2304 + 64 * (j))
#define XB_TOP      3328
#define XB_TOPGEN   3392
#define XCD_BAR_WORDS 3456
#define XB_SPIN_CAP (1u << 18)

__device__ __forceinline__ unsigned xb_ld(unsigned* p)              { return __hip_atomic_load(p, __ATOMIC_RELAXED, __HIP_MEMORY_SCOPE_AGENT); }
__device__ __forceinline__ unsigned xb_add(unsigned* p, unsigned v) { return __hip_atomic_fetch_add(p, v, __ATOMIC_RELAXED, __HIP_MEMORY_SCOPE_AGENT); }
__device__ __forceinline__ unsigned xb_xcc_id() { return (unsigned)__builtin_amdgcn_s_getreg((3 << 11) | 20) & 0xFu; }
#define XB_SPIN(cond, bar) do { unsigned _sp = 0; while (cond) { __builtin_amdgcn_s_sleep(1); \
    if ((++_sp & 255u) == 0u) { if (xb_ld(&(bar)[XB_TMO])) break; if (_sp > XB_SPIN_CAP) { atomicAdd(&(bar)[XB_TMO], 1u); break; } } } } while (0)

struct XcdBarrier {
    unsigned* bar; unsigned x;
    volatile LAS unsigned* st;
};

__device__ __forceinline__ XcdBarrier xcd_barrier_post(unsigned* bar, volatile LAS unsigned* st) {
    XcdBarrier b; b.bar = bar; b.x = xb_xcc_id(); b.st = st;
    if (threadIdx.x == 0) (void)xb_add(&bar[XB_XCNT(b.x)], 1u);
    return b;
}
__device__ __forceinline__ void xcd_barrier_complete(unsigned* bar, unsigned x, unsigned& nloc, unsigned& nx) {
    const unsigned G = gridDim.x * gridDim.y * gridDim.z;
    unsigned sum, cnt, mine, sp = 0u;
    for (;;) {
        sum = 0u; cnt = 0u; mine = 0u;
#pragma unroll
        for (unsigned j = 0; j < 16; ++j) { const unsigned c = xb_ld(&bar[XB_XCNT(j)]); sum += c; cnt += (c > 0u) ? 1u : 0u; mine = (j == x) ? c : mine; }
        if (sum == G) break;
        __builtin_amdgcn_s_sleep(1);
        if ((++sp & 255u) == 0u) { if (xb_ld(&bar[XB_TMO])) break; if (sp > XB_SPIN_CAP) { atomicAdd(&bar[XB_TMO], 1u); break; } }
    }
    nloc = mine > 0u ? mine : 1u; nx = cnt > 0u ? cnt : 1u;
}

__device__ __forceinline__ void xcd_barrier(const XcdBarrier& b) {
    asm volatile("s_waitcnt vmcnt(0)" ::: "memory");
    __syncthreads();
    if (threadIdx.x == 0) {
        unsigned* bar = b.bar;
        __builtin_amdgcn_s_waitcnt(0);
        unsigned nloc = b.st[0], nx = b.st[1];
        if (nloc == 0u) { xcd_barrier_complete(bar, b.x, nloc, nx); b.st[0] = nloc; b.st[1] = nx; }
        const unsigned old = xb_add(&bar[XB_XSUB(b.x)], 1u);
        const unsigned gen = old / nloc;
        if (old + 1u == (gen + 1u) * nloc) {
            __builtin_amdgcn_fence(__ATOMIC_RELEASE, "agent");
            asm volatile("s_waitcnt vmcnt(0)" ::: "memory");
            const unsigned og = xb_add(&bar[XB_TOP], 1u);
            const unsigned tg = og / nx;
            if (og + 1u == (tg + 1u) * nx) xb_add(&bar[XB_TOPGEN], 1u);
            else XB_SPIN(xb_ld(&bar[XB_TOPGEN]) == tg, bar);
            __builtin_amdgcn_fence(__ATOMIC_ACQUIRE, "agent");
            xb_add(&bar[XB_XGEN(b.x)], 1u);
            asm volatile("s_waitcnt vmcnt(0)" ::: "memory");
        } else {
            XB_SPIN(xb_ld(&bar[XB_XGEN(b.x)]) == gen, bar);
            __builtin_amdgcn_fence(__ATOMIC_ACQUIRE, "agent");
            asm volatile("s_waitcnt vmcnt(0)" ::: "memory");
        }
    }
    __syncthreads();
}

__global__ void __launch_bounds__(NTHREADS, 2) mega_fwd(Args args) {
    extern __shared__ __attribute__((aligned(16))) unsigned char lds[];
    Frame F;
    F.lds = (LAS unsigned char*)lds;
    F.wave = __builtin_amdgcn_readfirstlane((int)threadIdx.x >> 6);
    F.G = gridDim.x; { const int bx = blockIdx.x; F.vcu = (F.G % 8 == 0) ? (bx % 8) * (F.G / 8) + bx / 8 : bx; }
    F.out = args.out; F.ws = args.ws;
    const int lo = args.ph_lo, hi = args.ph_hi;
    if (threadIdx.x < 16) ((LAS unsigned*)(F.lds + LDS_BARST_OFF))[threadIdx.x] = 0u;
    __syncthreads();
    XcdBarrier bar = xcd_barrier_post((unsigned*)(F.ws + WS_CTL) + CW_BAR, (volatile LAS unsigned*)(F.lds + LDS_BARST_OFF));
#ifndef PHMASK
#define PHMASK 0x1ff
#endif
#define IN(k) (((PHMASK >> (k)) & 1) && lo <= (k) && (k) < hi)
#ifndef PHREP
#define PHREP 0
#endif
#define REP(k) (1 + ((PHREP >> (k)) & 1))
#ifndef CG_SEAM0
#define CG_SEAM0 0
#endif
#define SEAM(k) do { if (IN(k) && IN((k) + 1)) { if (CG_SEAM0 && (k) == 0) { asm volatile("s_waitcnt vmcnt(0)" ::: "memory"); __syncthreads(); cg::this_grid().sync(); } \
    xcd_barrier(bar); } } while (0)

    for (int rep_ = 0; rep_ < REP(0); ++rep_) { if (rep_) xcd_barrier(bar);

#if 1
    xcd_barrier(bar);
#endif
    if (IN(0)) { p0_prologue(F, kin(0), kin(1), kin(2), kin(3), kin(4), kin(11), kin(12), kin(13), kin(14), kin(17)); } } SEAM(0);
    for (int rep_ = 0; rep_ < REP(1); ++rep_) { if (rep_) xcd_barrier(bar);
    if (IN(1)) {
        pg8::Gemm g{(const pg8::bf16_t*)(F.ws + WS_XN), (const pg8::bf16_t*)(F.ws + WS_W1T), M, PROJ_LD, D};
        Sched1 S; S.init(F.G, (int)blockIdx.x);
        Epi1 E{(bf16*)(F.ws + WS_PROJ), (float*)(F.ws + WS_AB), (bf16*)(F.ws + WS_MKV)};
        pg8::gemm_phase<Epi1, Sched1, true, true>(F.lds, g, S, E, F.wave, fresh_lane());
    } } SEAM(1);
    for (int rep_ = 0; rep_ < REP(2); ++rep_) { if (rep_) xcd_barrier(bar);
    if (IN(2)) { for (int pair = F.vcu; pair < BATCH * GH * 32; pair += F.G) gdn_prep_pair(F, pair, kin(5), kin(6), kin(7)); } } SEAM(2);
    for (int rep_ = 0; rep_ < REP(3); ++rep_) { if (rep_) xcd_barrier(bar);
    if (IN(3)) {
#ifndef NO_GDN
#ifndef REP_SCAN
#define REP_SCAN 1
#endif
#ifndef REP_SBMEM
#define REP_SBMEM 1
#endif
        if (blockIdx.x < BATCH * GH) { for (int rs_ = 0; rs_ < REP_SCAN; ++rs_) gdn_scan_unit(F, (int)blockIdx.x, kin(8)); }
#else
        if (0) {}
#endif
        else {
            const int g2 = (int)blockIdx.x - BATCH * GH, NG2 = F.G - BATCH * GH;
            unsigned* kvflag = (unsigned*)(F.ws + WS_CTL) + CW_KVFLAG;
            const bool kvwg = NG2 >= 64 && g2 >= 32 && g2 < 48;
            if (NG2 < 64 ? (g2 == 0) : kvwg) {
                for (int e = (NG2 < 64 ? 0 : g2 - 32); e < 16; e += (NG2 < 64 ? 1 : 16)) {
                    pg8::Gemm g{(const pg8::bf16_t*)(F.ws + WS_XN), (const pg8::bf16_t*)(F.ws + WS_W1T), M, N1, D};
                    SchedKV S{e}; Epi1 E{(bf16*)(F.ws + WS_PROJ), (float*)(F.ws + WS_AB), (bf16*)(F.ws + WS_MKV)};
                    pg8::gemm_phase<Epi1, SchedKV, true, true>(F.lds, g, S, E, F.wave, fresh_lane());
                }
                asm volatile("s_waitcnt vmcnt(0)" ::: "memory");
                __syncthreads();
                if (threadIdx.x == 0) { __builtin_amdgcn_fence(__ATOMIC_RELEASE, "agent"); __hip_atomic_fetch_add(kvflag, (NG2 < 64 ? 16u : 1u), __ATOMIC_RELAXED, __HIP_MEMORY_SCOPE_AGENT); }
            }
#ifndef NO_SB
            for (int unit = g2; unit < 256; unit += NG2) sb_unit(F, unit, kin(9));
#endif
            {
                __syncthreads();
                const int lane_t = fresh_lane(); LAS float* scr = (LAS float*)(F.lds + F.wave * 16384);
                constexpr int I_O = (D / 64) * (D / 32);
                for (int it = g2 * NWAVES + F.wave; it < 2 * I_O; it += NG2 * NWAVES) {
                    if (it < I_O) transpose_item<false>(kin(14), D, D, (bf16*)(F.ws + WS_WOT), 0, scr, it, lane_t);
                    else transpose_item<false>(kin(17), D, D, (bf16*)(F.ws + WS_WQT), 0, scr, it - I_O, lane_t);
                }
                {
                    const int gt = NG2 >= 64 ? (g2 >= 48 ? g2 - 48 : -1) : g2, ngt = NG2 >= 64 ? NG2 - 48 : NG2;
                    peer_tables_convert(F, kin(20), kin(21), gt < 0 ? 2 * PE_NEXP : gt * NWAVES + F.wave, ngt * NWAVES, g2 * NWAVES + F.wave);
                }
            }
            if (threadIdx.x == 0) { unsigned sp_ = 0; while (__hip_atomic_load(kvflag, __ATOMIC_RELAXED, __HIP_MEMORY_SCOPE_AGENT) < 16u) { __builtin_amdgcn_s_sleep(2); if (++sp_ > (1u << 22)) break; } }
            __syncthreads();
#ifndef NO_MEM
            for (int unit = 255 - g2; unit >= 0; unit -= NG2) mem_unit(F, unit, kin(10));
#endif
        }
    } } SEAM(3);
    for (int rep_ = 0; rep_ < REP(4); ++rep_) { if (rep_) xcd_barrier(bar);
    if (IN(4)) {
        pg8::Gemm g{(const pg8::bf16_t*)(F.ws + WS_OMIX), (const pg8::bf16_t*)(F.ws + WS_WOT), M, D, D};
        pg8::StaticOrder S; S.init(M, D, F.G, (int)blockIdx.x);
        Epi2 E{(const bf16*)(F.ws + WS_XN), (bf16*)(F.ws + WS_Y1)};
        pg8::gemm_phase<Epi2, pg8::StaticOrder, true, true>(F.lds, g, S, E, F.wave, fresh_lane());
    } } SEAM(4);
    for (int rep_ = 0; rep_ < REP(5); ++rep_) { if (rep_) xcd_barrier(bar);
    if (IN(5)) { p5_ln1_tables(F, kin(15), kin(16), kin(20), kin(21)); } } SEAM(5);
    for (int rep_ = 0; rep_ < REP(6); ++rep_) { if (rep_) xcd_barrier(bar);
    if (IN(6)) {
        pg8::Gemm g{(const pg8::bf16_t*)(F.ws + WS_XN), (const pg8::bf16_t*)(F.ws + WS_WQT), M, D, D};
        pg8::StaticOrder S; S.init(M, D, F.G, (int)blockIdx.x);
        Epi3 E{(bf16*)(F.ws + WS_Q)};
        pg8::gemm_phase<Epi3, pg8::StaticOrder, true, true>(F.lds, g, S, E, F.wave, fresh_lane());
    } } SEAM(6);
    for (int rep_ = 0; rep_ < REP(7); ++rep_) { if (rep_) xcd_barrier(bar);
    if (IN(7)) { p7_peer_scores(F, kin(18), kin(19)); } } SEAM(7);
    for (int rep_ = 0; rep_ < REP(8); ++rep_) { if (rep_) xcd_barrier(bar);
#ifndef REP_P8A
#define REP_P8A 1
#endif
#ifndef REP_P8B
#define REP_P8B 1
#endif
    if (IN(8)) { for (int r8_ = 0; r8_ < REP_P8A; ++r8_) p8a_peer_u(F); xcd_barrier(bar); for (int r8_ = 0; r8_ < REP_P8B; ++r8_) p8_peer_experts(F, kin(22), kin(23)); } }
#undef IN
#undef SEAM
}

extern "C" void kernel_launch(void* const* d_in, const int* in_sizes, int n_in, void* d_out, int out_size, void* d_ws, size_t ws_size, hipStream_t stream) {
    static int grid = 0;
    if (grid == 0) {
        if (n_in != 24 || out_size != M * D || ws_size < WS_END) { fprintf(stderr, "kernel_launch: unexpected problem: n_in %d out %d ws %zu\n", n_in, out_size, ws_size); grid = -1; return; }
        int dev = 0, cus = 0, per_cu = 0;
        if (hipGetDevice(&dev) != hipSuccess || hipDeviceGetAttribute(&cus, hipDeviceAttributeMultiprocessorCount, dev) != hipSuccess) { grid = -1; return; }
        if (hipFuncSetAttribute((const void*)mega_fwd, hipFuncAttributeMaxDynamicSharedMemorySize, LDS_BYTES) != hipSuccess) { fprintf(stderr, "kernel_launch: hipFuncSetAttribute failed\n"); grid = -1; return; }
        if (hipOccupancyMaxActiveBlocksPerMultiprocessor(&per_cu, (const void*)mega_fwd, NTHREADS, LDS_BYTES) != hipSuccess || per_cu < 1) { fprintf(stderr, "kernel_launch: occupancy query says %d\n", per_cu); per_cu = 1; }
        (void)hipGetLastError();
        grid = cus * (per_cu >= 1 ? 1 : 0);
        fprintf(stderr, "kernel_launch: grid %d (cus %d, occupancy/CU %d), ws %zu\n", grid, cus, per_cu, ws_size);
    }
    if (grid <= 0) return;
    (void)hipMemsetAsync((char*)d_ws + WS_CTL, 0, CTL_ZERO_BYTES, stream);
    Args a{};
    for (int i = 0; i < 24; ++i) a.in[i] = (const float*)d_in[i];
    a.out = (float*)d_out; a.ws = (unsigned char*)d_ws;
#if MK_N_LAUNCHES == 1
    a.ph_lo = 0; a.ph_hi = NPHASES;
    void* kargs[] = {&a};
    hipError_t e = hipLaunchCooperativeKernel((const void*)mega_fwd, dim3(grid), dim3(NTHREADS), kargs, LDS_BYTES, stream);
    if (e != hipSuccess) fprintf(stderr, "kernel_launch: cooperative launch failed: %s\n", hipGetErrorString(e));
#else
    for (int p = 0; p < NPHASES; ++p) { a.ph_lo = p; a.ph_hi = p + 1; hipLaunchKernelGGL(mega_fwd, dim3(grid), dim3(NTHREADS), LDS_BYTES, stream, a); }
#endif
}
```

```cpp
#include <hip/hip_runtime.h>
#include <hip/hip_cooperative_groups.h>
#include <cstdio>
#include <cstdint>
#include <cmath>
namespace cg = cooperative_groups;

namespace pg8 {
#define PG8_LAS __attribute__((address_space(3)))
typedef unsigned short bf16_t;
typedef short bf16x8 __attribute__((ext_vector_type(8)));
typedef float f32x4 __attribute__((ext_vector_type(4)));
typedef unsigned u32x4 __attribute__((ext_vector_type(4)));
constexpr int BM = 256, BK = 64, HALF = 128, HTB = HALF * BK * 2  , STAGE_BYTES = 8 * HTB, NXCD = 8, WGM = 8;

__host__ __device__ __forceinline__ int lds_byte(int r, int c) { const int st = (r >> 4) * 2 + (c >> 5), rr = r & 15, cc = c & 31, ob = rr * 64 + cc * 2; return st * 1024 + (ob ^ (((ob >> 9) & 1) << 5)); }
__host__ __device__ __forceinline__ void stage_rc(int b, int& R, int& C) { const int st = b / 1024, sb = b % 1024, swz = sb ^ (((sb >> 9) & 1) << 5); R = (st >> 1) * 16 + swz / 64; C = (st & 1) * 32 + (swz % 64) / 2; }
__host__ __device__ __forceinline__ int perm32(int rho) { const int n = rho >> 4, i = rho & 15; return 8 * (i >> 2) + 4 * n + (i & 3); }

struct Unit { int pm, pn; };
struct Gemm { const bf16_t* A; const bf16_t* Bt; int M, N, K; };

struct StaticOrder {
    int nM, nN, nwg, G, c;
    __host__ __device__ void init(int M, int N, int G_, int c_) { nM = M / BM; nN = N / BM; nwg = nM * nN; G = G_; c = c_; }
    __host__ __device__ bool next(int i, Unit& u) const {
        const long L = (long)i * G + c; if (L >= nwg) return false;
        int wgid = (int)L; { const int q = nwg / NXCD, r = nwg % NXCD, xcd = wgid % NXCD, off = wgid / NXCD; wgid = (xcd < r ? xcd * (q + 1) : r * (q + 1) + (xcd - r) * q) + off; }
        const int nig = WGM * nN, gid = wgid / nig, fm = gid * WGM, gsz = (nM - fm) < WGM ? (nM - fm) : WGM;
        u.pm = fm + ((wgid % nig) % gsz); u.pn = (wgid % nig) / gsz; return true;
    }
    __device__ __forceinline__ void a_ready(const Unit&) const {}
    __device__ __forceinline__ void done(const Unit&) const {}
};

__device__ __forceinline__ unsigned cvt_pk_bf16(float lo, float hi) { unsigned r; asm volatile("v_cvt_pk_bf16_f32 %0, %1, %2" : "=v"(r) : "v"(lo), "v"(hi)); return r; }
typedef float f32x2 __attribute__((ext_vector_type(2)));
__device__ __forceinline__ f32x2 gelu_pk(f32x2 v) {
    const f32x2 av = __builtin_elementwise_abs(v), d = av * 0.2316418882f + 1.0f;
    f32x2 t; t.x = __builtin_amdgcn_rcpf(d.x); t.y = __builtin_amdgcn_rcpf(d.y);
    f32x2 q = t * 0.5307027145f + (-0.7265760135f); q = q * t + 0.7107068705f; q = q * t + (-0.142248368f); q = q * t + 0.127414796f; q = q * t;
    const f32x2 s = (v * v) * (-0.72134752044f);
    f32x2 e; e.x = __builtin_amdgcn_exp2f(s.x); e.y = __builtin_amdgcn_exp2f(s.y);
    const f32x2 m = v * (q * e), r = v - m;
    f32x2 o; o.x = v.x < 0.f ? m.x : r.x; o.y = v.y < 0.f ? m.y : r.y; return o;
}

template <int ACT  > struct EpiBf16 {
    static constexpr bool PERM = true, AFTER_DRAIN = false; static_assert(ACT == 0 || ACT == 1, "EpiBf16: ACT is 0 (none) or 1 (gelu_pk)");
    bf16_t* O; int ldc; const float* bias; int split_cols; size_t split_stride; float scale0;
    __device__ __forceinline__ void operator()(const f32x4 (&acc)[2][2][4][2], const Unit& u, int wr, int wc, int fr, int fq) const {
        const int row0 = u.pm * BM + wr * 64 + fr; int colt = u.pn * BM; bf16_t* base = O;
        float sc = 1.f; if (split_cols) { const int t = colt / split_cols; base += (size_t)t * split_stride; colt -= t * split_cols; if (t == 0) sc = scale0; }
        const int col0 = colt + wc * 32 + 8 * fq, bcol0 = u.pn * BM + wc * 32 + 8 * fq;
        f32x4 bv[2][2];
#pragma unroll
        for (int bj = 0; bj < 2; ++bj)
#pragma unroll
            for (int n = 0; n < 2; ++n) bv[bj][n] = bias ? *(const f32x4*)(bias + bcol0 + bj * HALF + 4 * n) : (f32x4){0.f, 0.f, 0.f, 0.f};
#pragma unroll
        for (int ai = 0; ai < 2; ++ai)
#pragma unroll
            for (int m = 0; m < 4; ++m) { bf16_t* rowp = base + (size_t)(row0 + ai * HALF + m * 16) * ldc + col0;
#pragma unroll
                for (int bj = 0; bj < 2; ++bj) { f32x4 v0 = acc[ai][bj][m][0] + bv[bj][0], v1 = acc[ai][bj][m][1] + bv[bj][1];
                    if (ACT == 1) { f32x2 a = gelu_pk((f32x2){v0[0], v0[1]}), b = gelu_pk((f32x2){v0[2], v0[3]}), c = gelu_pk((f32x2){v1[0], v1[1]}), d = gelu_pk((f32x2){v1[2], v1[3]});
                        v0 = (f32x4){a.x, a.y, b.x, b.y}; v1 = (f32x4){c.x, c.y, d.x, d.y}; }
                    v0 = v0 * sc; v1 = v1 * sc; u32x4 w; w.x = cvt_pk_bf16(v0[0], v0[1]); w.y = cvt_pk_bf16(v0[2], v0[3]); w.z = cvt_pk_bf16(v1[0], v1[1]); w.w = cvt_pk_bf16(v1[2], v1[3]);
                    *(u32x4*)(rowp + bj * HALF) = w; } }
    }
};

template <class Epi, class Sched, bool ALIGN_EPI = false, bool SP2 = false>
__device__ __forceinline__ void gemm_phase(PG8_LAS unsigned char* lds, const Gemm g, const Sched& S, const Epi& E, const int wid, const int lane) {
    const int tid = wid * 64 + lane, wr = wid >> 2, wc = wid & 3, fr = lane & 15, fq = lane >> 4;
    const int K = g.K, nt = K / BK;
    unsigned voffA[2], voffB[2];
#pragma unroll
    for (int i = 0; i < 2; ++i) { int R, C; stage_rc(tid * 16 + i * 8192, R, C); const int Rb = Epi::PERM ? ((R & ~31) + perm32(R & 31)) : R;
        voffA[i] = (unsigned)(R * K + C) * 2u; voffB[i] = (unsigned)(Rb * K + C) * 2u; }
    const size_t kstep = (size_t)(BK * 2);
    const size_t hstep = (size_t)HALF * K * 2;
    const size_t tstep = 2 * hstep;
    const unsigned ldsw = (unsigned)wid * 1024u;
    const int aoff = lds_byte(wr * 64 + fr, fq * 8), boff = lds_byte(wc * 32 + fr, fq * 8);
#define PG8_SA(b, h) (((b) * 2 + (h)) * HTB)
#define PG8_SB(b, h) ((4 + (b) * 2 + (h)) * HTB)
#define PG8_STAGE(bufoff, gbase, voff) do { _Pragma("unroll") for (int _i = 0; _i < 2; ++_i) \
        __builtin_amdgcn_global_load_lds((const unsigned*)((const char*)(gbase) + (voff)[_i]), (PG8_LAS unsigned*)(lds + (bufoff) + ldsw + _i * 8192), 16, 0, 0); } while (0)
#define PG8_LDA(dst, b, h) do { _Pragma("unroll") for (int m = 0; m < 4; ++m) _Pragma("unroll") for (int k = 0; k < 2; ++k) dst[m][k] = *(const PG8_LAS bf16x8*)(lds + PG8_SA(b, h) + aoff + m * 2048 + k * 1024); } while (0)
#define PG8_LDB(dst, b, h) do { _Pragma("unroll") for (int n = 0; n < 2; ++n) _Pragma("unroll") for (int k = 0; k < 2; ++k) dst[n][k] = *(const PG8_LAS bf16x8*)(lds + PG8_SB(b, h) + boff + n * 2048 + k * 1024); } while (0)
#define PG8_MMA(ai, bj, At, Bt) do { __builtin_amdgcn_s_setprio(1); _Pragma("unroll") for (int m = 0; m < 4; ++m) _Pragma("unroll") for (int n = 0; n < 2; ++n) _Pragma("unroll") for (int k = 0; k < 2; ++k) \
        acc[ai][bj][m][n] = __builtin_amdgcn_mfma_f32_16x16x32_bf16(Bt[n][k], At[m][k], acc[ai][bj][m][n], 0, 0, 0); __builtin_amdgcn_s_setprio(0); } while (0)
#define PG8_WAIT_V(n) asm volatile("s_waitcnt vmcnt(" #n ")" ::: "memory")
#define PG8_WAIT_L(n) asm volatile("s_waitcnt lgkmcnt(" #n ")" ::: "memory")
#define PG8_BAR __builtin_amdgcn_s_barrier()
#define PG8_SCHED __builtin_amdgcn_sched_barrier(0)
    Unit cur, nxt; int ui = 0;
    if (!S.next(0, cur)) return;
    f32x4 acc[2][2][4][2];
#pragma unroll
    for (int a = 0; a < 2; ++a)
#pragma unroll
        for (int b = 0; b < 2; ++b)
#pragma unroll
            for (int m = 0; m < 4; ++m)
#pragma unroll
                for (int n = 0; n < 2; ++n) acc[a][b][m][n] = (f32x4){0.f, 0.f, 0.f, 0.f};
    bf16x8 At[4][2], B0[2][2], B1[2][2];
    const char* cA = (const char*)g.A + (size_t)cur.pm * tstep; const char* cB = (const char*)g.Bt + (size_t)cur.pn * tstep;
    S.a_ready(cur);
    if constexpr (SP2) {
        PG8_STAGE(PG8_SB(0, 0), cB, voffB); PG8_STAGE(PG8_SB(0, 1), cB + hstep, voffB); PG8_STAGE(PG8_SA(0, 0), cA, voffA); PG8_STAGE(PG8_SA(0, 1), cA + hstep, voffA);
        if (wr == 1) PG8_BAR;
        PG8_WAIT_V(2); PG8_BAR;
        PG8_STAGE(PG8_SB(1, 0), cB + kstep, voffB); PG8_STAGE(PG8_SA(1, 0), cA + kstep, voffA); PG8_STAGE(PG8_SB(1, 1), cB + hstep + kstep, voffB);
        PG8_WAIT_V(6); PG8_BAR;
    } else {
        PG8_STAGE(PG8_SB(0, 0), cB, voffB); PG8_STAGE(PG8_SA(0, 0), cA, voffA); PG8_STAGE(PG8_SB(0, 1), cB + hstep, voffB); PG8_STAGE(PG8_SA(0, 1), cA + hstep, voffA);
        if (wr == 1) PG8_BAR;
        PG8_WAIT_V(4); PG8_BAR;
        PG8_STAGE(PG8_SB(1, 0), cB + kstep, voffB); PG8_STAGE(PG8_SA(1, 0), cA + kstep, voffA); PG8_STAGE(PG8_SB(1, 1), cB + hstep + kstep, voffB);
        PG8_WAIT_V(6); PG8_BAR;
    }
    for (;;) {
        const bool has_next = S.next(ui + 1, nxt);
        const char* nA = has_next ? (const char*)g.A + (size_t)nxt.pm * tstep : cA; const char* nB = has_next ? (const char*)g.Bt + (size_t)nxt.pn * tstep : cB;
        for (int t = 0; t < nt; t += 2) {
            const bool last = (t == nt - 2);
            const char* a1 = cA + (size_t)(t + 1) * kstep;
            const char* a2 = last ? nA : cA + (size_t)(t + 2) * kstep; const char* b2 = last ? nB : cB + (size_t)(t + 2) * kstep;
            const char* a3 = a2 + kstep; const char* b3 = b2 + kstep;
            if (last && has_next) S.a_ready(nxt);
            if constexpr (SP2) {
            PG8_LDB(B0, 0, 0); PG8_LDB(B1, 0, 1); PG8_SCHED; PG8_LDA(At, 0, 0); PG8_STAGE(PG8_SA(1, 1), a1 + hstep, voffA);
            PG8_WAIT_V(8); PG8_WAIT_L(0); PG8_BAR; PG8_MMA(0, 0, At, B0); PG8_MMA(0, 1, At, B1); PG8_BAR; PG8_SCHED;
            PG8_LDA(At, 0, 1); PG8_STAGE(PG8_SB(0, 0), b2, voffB); PG8_STAGE(PG8_SB(0, 1), b2 + hstep, voffB); PG8_STAGE(PG8_SA(0, 0), a2, voffA);
            PG8_WAIT_V(8); PG8_WAIT_L(0); PG8_BAR; PG8_MMA(1, 0, At, B0); PG8_MMA(1, 1, At, B1); PG8_BAR; PG8_SCHED;
            PG8_LDB(B0, 1, 0); PG8_LDB(B1, 1, 1); PG8_SCHED; PG8_LDA(At, 1, 0); PG8_STAGE(PG8_SA(0, 1), a2 + hstep, voffA);
            PG8_WAIT_V(8); PG8_WAIT_L(0); PG8_BAR; PG8_MMA(0, 0, At, B0); PG8_MMA(0, 1, At, B1); PG8_BAR; PG8_SCHED;
            PG8_LDA(At, 1, 1); PG8_STAGE(PG8_SB(1, 0), b3, voffB); PG8_STAGE(PG8_SB(1, 1), b3 + hstep, voffB); PG8_STAGE(PG8_SA(1, 0), a3, voffA);
            PG8_WAIT_V(8); PG8_WAIT_L(0); PG8_BAR; PG8_MMA(1, 0, At, B0); PG8_MMA(1, 1, At, B1); PG8_BAR; PG8_SCHED;
            } else {
            PG8_LDB(B0, 0, 0); PG8_SCHED; PG8_LDA(At, 0, 0); PG8_STAGE(PG8_SA(1, 1), a1 + hstep, voffA);
            PG8_WAIT_L(8); PG8_BAR; PG8_WAIT_L(0); PG8_MMA(0, 0, At, B0); PG8_BAR; PG8_SCHED;
            PG8_LDB(B1, 0, 1); PG8_STAGE(PG8_SB(0, 0), b2, voffB);
            PG8_BAR; PG8_WAIT_L(0); PG8_MMA(0, 1, At, B1); PG8_BAR;
            PG8_LDA(At, 0, 1); PG8_STAGE(PG8_SA(0, 0), a2, voffA);
            PG8_BAR; PG8_WAIT_L(0); PG8_MMA(1, 0, At, B0); PG8_BAR; PG8_SCHED;
            PG8_STAGE(PG8_SB(0, 1), b2 + hstep, voffB);
            PG8_WAIT_V(6); PG8_BAR; PG8_MMA(1, 1, At, B1); PG8_BAR;
            PG8_LDB(B0, 1, 0); PG8_SCHED; PG8_LDA(At, 1, 0); PG8_STAGE(PG8_SA(0, 1), a2 + hstep, voffA);
            PG8_WAIT_L(8); PG8_BAR; PG8_WAIT_L(0); PG8_MMA(0, 0, At, B0); PG8_BAR; PG8_SCHED;
            PG8_LDB(B1, 1, 1); PG8_STAGE(PG8_SB(1, 0), b3, voffB);
            PG8_BAR; PG8_WAIT_L(0); PG8_MMA(0, 1, At, B1); PG8_BAR;
            PG8_LDA(At, 1, 1); PG8_STAGE(PG8_SA(1, 0), a3, voffA);
            PG8_BAR; PG8_WAIT_L(0); PG8_MMA(1, 0, At, B0); PG8_BAR; PG8_SCHED;
            PG8_STAGE(PG8_SB(1, 1), b3 + hstep, voffB);
            PG8_WAIT_V(6); PG8_BAR; PG8_MMA(1, 1, At, B1); PG8_BAR;
            }
        }
        if constexpr (ALIGN_EPI) { if (wr == 0) PG8_BAR; }
        if constexpr (!Epi::AFTER_DRAIN) { E(acc, cur, wr, wc, fr, fq); S.done(cur); }
        if (!has_next) break;
#pragma unroll
        for (int a = 0; a < 2; ++a)
#pragma unroll
            for (int b = 0; b < 2; ++b)
#pragma unroll
                for (int m = 0; m < 4; ++m)
#pragma unroll
                    for (int n = 0; n < 2; ++n) acc[a][b][m][n] = (f32x4){0.f, 0.f, 0.f, 0.f};
        cur = nxt; cA = nA; cB = nB; ++ui;
        if constexpr (ALIGN_EPI) { if (wr == 1) PG8_BAR; }
    }
    PG8_WAIT_V(0);
    if constexpr (!ALIGN_EPI) { if (wr == 0) PG8_BAR; }
    PG8_BAR;
    if constexpr (Epi::AFTER_DRAIN) { E.fused(acc, cur, wr, wc, fr, fq, lds, wid, lane); S.done(cur); }
#undef PG8_SA
#undef PG8_SB
#undef PG8_STAGE
#undef PG8_LDA
#undef PG8_LDB
#undef PG8_MMA
#undef PG8_WAIT_V
#undef PG8_WAIT_L
#undef PG8_BAR
#undef PG8_SCHED
}
}

#ifndef MK_N_LAUNCHES
#define MK_N_LAUNCHES 1
#endif
constexpr int NWAVES = 8, NTHREADS = 512;
constexpr int BATCH = 4, SEQ = 4096, M = BATCH * SEQ, D = 2048, NMEM = 256, HD = 128;
constexpr int GH = 8, SBH = 4, MEMH = 4;
constexpr int IN_COLS = 6160, N1 = 6400, NKV = 1024;
constexpr int PROJ_LD = 6144, QKV_LD = 3072;
constexpr int PE_HEADS = 8, PE_KEYS = 128, PE_TOPK = 16, PE_NEXP = 16384, PE_SEL = PE_HEADS * PE_TOPK;
constexpr float ALPHA = 1.189207115002721f;
constexpr float LN_EPS = 1e-5f, RMS_EPS = 1e-6f;
constexpr int NPHASES = 9;

constexpr size_t MiB = 1u << 20;
constexpr size_t WS_CTL = 0, CTL_ZERO_BYTES = 65536;
constexpr size_t WS_W1T = 1 * MiB;
constexpr size_t WS_IDX = 1 * MiB, WS_GATE = 9 * MiB;
constexpr size_t WS_WOT = 30 * MiB;
constexpr size_t WS_WQT = 38 * MiB;
constexpr size_t WS_AB = 46 * MiB;
constexpr size_t WS_MKV = 47 * MiB;
constexpr size_t WS_XN = 49 * MiB;
constexpr size_t WS_PROJ = 117 * MiB;
constexpr size_t WS_Y1 = 117 * MiB;
constexpr size_t WS_OMIX = 309 * MiB;
constexpr size_t WS_Q = 309 * MiB;
constexpr size_t WS_QKVN = 373 * MiB;
constexpr size_t WS_UT = 373 * MiB, WS_VT = 405 * MiB;
constexpr size_t WS_G = 469 * MiB, WS_BETA = 469 * MiB + 512 * 1024;
constexpr size_t WS_QKF = 1 * MiB, WS_GL = 17 * MiB;
constexpr size_t WS_USTEP = 438 * MiB, WS_VSTEP = 437 * MiB;
constexpr size_t WS_PART = 181 * MiB;
constexpr size_t WS_XQ = 245 * MiB, WS_XSTEP = 277 * MiB;
constexpr size_t UT_SLICE = (size_t)16384 * 128, US_OFF = 16 * MiB, US_SLICE = (size_t)16384 * 16;
constexpr size_t WS_SMW = 20 * MiB;
constexpr int CW_KVFLAG = 9200;
constexpr size_t WS_END = 501 * MiB;

typedef unsigned short bf16;
#define GAS __attribute__((address_space(1)))
#define LAS __attribute__((address_space(3)))
typedef unsigned v4u __attribute__((ext_vector_type(4)));
typedef unsigned v2u __attribute__((ext_vector_type(2)));
typedef float f32x4 __attribute__((ext_vector_type(4)));

constexpr int LDS_BYTES = 163840;

typedef float f32x2_t __attribute__((ext_vector_type(2)));
typedef __bf16 bf16x2_t __attribute__((ext_vector_type(2)));
__device__ __forceinline__ unsigned cvtpk(float lo, float hi) { f32x2_t v = {lo, hi}; bf16x2_t b = __builtin_convertvector(v, bf16x2_t); return __builtin_bit_cast(unsigned, b); }
__device__ __forceinline__ unsigned f2bf(float f) { return cvtpk(f, f) & 0xffffu; }
__device__ __forceinline__ unsigned pk2(float lo, float hi) { return cvtpk(lo, hi); }
__device__ __forceinline__ float bflo(unsigned u) { return __builtin_bit_cast(float, u << 16); }
__device__ __forceinline__ float bfhi(unsigned u) { return __builtin_bit_cast(float, u & 0xffff0000u); }
__device__ __forceinline__ float bf2f(bf16 h) { return __builtin_bit_cast(float, (unsigned)h << 16); }
__device__ __forceinline__ float wave_sum(float v) {
#pragma unroll
    for (int o = 1; o < 64; o <<= 1) v += __shfl_xor(v, o);
    return v;
}
__device__ __forceinline__ float wave_max(float v) {
#pragma unroll
    for (int o = 1; o < 64; o <<= 1) v = fmaxf(v, __shfl_xor(v, o));
    return v;
}
__device__ __forceinline__ float softplus_f(float x) { return x > 20.f ? x : log1pf(__expf(x)); }
__device__ __forceinline__ float sigmoid_f(float x) { return __builtin_amdgcn_rcpf(1.f + __expf(-x)); }
__device__ __forceinline__ float silu_f(float x) { return x * __builtin_amdgcn_rcpf(1.f + __expf(-x)); }

struct Args { const float* in[24]; float* out; unsigned char* ws; int ph_lo, ph_hi; };

__device__ __forceinline__ const float* kin(int k) {
    const __attribute__((address_space(4))) unsigned long long* kp = (const __attribute__((address_space(4))) unsigned long long*)__builtin_amdgcn_kernarg_segment_ptr();
    return (const float*)kp[k];
}
__device__ __forceinline__ int fresh_lane() { unsigned z = 0u; asm volatile("" : "+v"(z)); return (int)__builtin_amdgcn_mbcnt_hi(~0u, __builtin_amdgcn_mbcnt_lo(~0u, z)); }
struct Frame {
    LAS unsigned char* lds;
    int wave, vcu, G;
    float* out; unsigned char* ws;
};

__device__ __forceinline__ int w1_dest_row(int n) { return n < 4096 ? n : (n < 4112 ? 6144 + (n - 4096) : n - 16); }
template <bool PERMUTE>
__device__ __forceinline__ void transpose_item(const float* W, int K, int N, bf16* WT, int row_off, LAS float* scr, int item, int lane) {
    const int nblk = (N + 31) / 32, kb = item / nblk, nb = item % nblk, k0 = 64 * kb, n0 = 32 * nb;
    const int ncol = n0 + (lane & 31);
    float tv[32];
#pragma unroll
    for (int i = 0; i < 32; ++i) { const int kk = 2 * i + (lane >> 5); tv[i] = (ncol < N) ? W[(size_t)(k0 + kk) * N + ncol] : 0.f; }
#pragma unroll
    for (int i = 0; i < 32; ++i) { const int kk = 2 * i + (lane >> 5); scr[kk * 33 + (lane & 31)] = tv[i]; }
    asm volatile("s_waitcnt lgkmcnt(0)" ::: "memory");
    const int c = lane & 7;
#pragma unroll
    for (int j = 0; j < 4; ++j) { const int n = (lane >> 3) + 8 * j; const LAS float* s = scr + (8 * c) * 33 + n;
        v4u o; o.x = pk2(s[0 * 33], s[1 * 33]); o.y = pk2(s[2 * 33], s[3 * 33]); o.z = pk2(s[4 * 33], s[5 * 33]); o.w = pk2(s[6 * 33], s[7 * 33]);
        const int ng = n0 + n;
        if (ng < N) { const int dr = PERMUTE ? w1_dest_row(ng) : ng; *(v4u*)(WT + (size_t)(row_off + dr) * K + k0 + 8 * c) = o; } }
    asm volatile("s_waitcnt lgkmcnt(0)" ::: "memory");
}
__device__ __forceinline__ void ln_row_bf16(const float* xrow, const float* w, const float* b, bf16* orow, int lane) {
    const f32x4* xr = (const f32x4*)xrow + lane;
    f32x4 v[8]; float s = 0.f;
#pragma unroll
    for (int j = 0; j < 8; ++j) { v[j] = xr[64 * j]; s += (v[j].x + v[j].y) + (v[j].z + v[j].w); }
    const float mean = wave_sum(s) * (1.f / D); float s2 = 0.f;
#pragma unroll
    for (int j = 0; j < 8; ++j) { v[j] = v[j] - mean; s2 += (v[j].x * v[j].x + v[j].y * v[j].y) + (v[j].z * v[j].z + v[j].w * v[j].w); }
    const float rstd = 1.f / sqrtf(wave_sum(s2) * (1.f / D) + LN_EPS);
    v2u* o8 = (v2u*)orow + lane;
#pragma unroll
    for (int j = 0; j < 8; ++j) { const f32x4 ww = ((const f32x4*)w)[lane + 64 * j], bb = ((const f32x4*)b)[lane + 64 * j];
        v2u o; o.x = pk2(v[j].x * rstd * ww.x + bb.x, v[j].y * rstd * ww.y + bb.y); o.y = pk2(v[j].z * rstd * ww.z + bb.z, v[j].w * rstd * ww.w + bb.w); o8[64 * j] = o; }
}
__device__ __forceinline__ void ln_rows2_bf16(const float* xa, const float* xb, const float* w, const float* b, bf16* oa, bf16* ob, const LAS unsigned char* wab, float* aba, float* abb, int lane) {
    const f32x4* pa = (const f32x4*)xa + lane; const f32x4* pb = (const f32x4*)xb + lane;
    f32x4 va[8], vb[8];
#pragma unroll
    for (int j = 0; j < 8; ++j) { va[j] = pa[64 * j]; vb[j] = pb[64 * j]; }
    float sa = 0.f, sb = 0.f;
#pragma unroll
    for (int j = 0; j < 8; ++j) { sa += (va[j].x + va[j].y) + (va[j].z + va[j].w); sb += (vb[j].x + vb[j].y) + (vb[j].z + vb[j].w); }
#pragma unroll
    for (int o = 1; o < 64; o <<= 1) { sa += __shfl_xor(sa, o); sb += __shfl_xor(sb, o); }
    const float ma = sa * (1.f / D), mb = sb * (1.f / D); float qa = 0.f, qb = 0.f;
#pragma unroll
    for (int j = 0; j < 8; ++j) { va[j] = va[j] - ma; vb[j] = vb[j] - mb;
        qa += (va[j].x * va[j].x + va[j].y * va[j].y) + (va[j].z * va[j].z + va[j].w * va[j].w); qb += (vb[j].x * vb[j].x + vb[j].y * vb[j].y) + (vb[j].z * vb[j].z + vb[j].w * vb[j].w); }
#pragma unroll
    for (int o = 1; o < 64; o <<= 1) { qa += __shfl_xor(qa, o); qb += __shfl_xor(qb, o); }
    const float ra = 1.f / sqrtf(qa * (1.f / D) + LN_EPS), rb = 1.f / sqrtf(qb * (1.f / D) + LN_EPS);
    v2u* o8a = (v2u*)oa + lane; v2u* o8b = (v2u*)ob + lane;
    float da[16], db[16];
#pragma unroll
    for (int c = 0; c < 16; ++c) { da[c] = 0.f; db[c] = 0.f; }
#pragma unroll
    for (int j = 0; j < 8; ++j) { const f32x4 ww = ((const f32x4*)w)[lane + 64 * j], bb = ((const f32x4*)b)[lane + 64 * j];
        f32x4 ya, yb;
        ya.x = va[j].x * ra * ww.x + bb.x; ya.y = va[j].y * ra * ww.y + bb.y; ya.z = va[j].z * ra * ww.z + bb.z; ya.w = va[j].w * ra * ww.w + bb.w;
        yb.x = vb[j].x * rb * ww.x + bb.x; yb.y = vb[j].y * rb * ww.y + bb.y; yb.z = vb[j].z * rb * ww.z + bb.z; yb.w = vb[j].w * rb * ww.w + bb.w;
        v2u o; o.x = pk2(ya.x, ya.y); o.y = pk2(ya.z, ya.w); o8a[64 * j] = o;
        v2u p; p.x = pk2(yb.x, yb.y); p.y = pk2(yb.z, yb.w); o8b[64 * j] = p;
#pragma unroll
        for (int i = 0; i < 4; ++i) { const float yai = ya[i], ybi = yb[i];
#pragma unroll
            for (int hh = 0; hh < 2; ++hh) { const v4u w8 = *(const LAS v4u*)(wab + (size_t)(((j * 8 + 2 * i + hh) * 64 + lane) * 16));
#pragma unroll
                for (int d = 0; d < 4; ++d) { const float w0 = bflo(w8[d]), w1 = bfhi(w8[d]);
                    da[8 * hh + 2 * d] += yai * w0; da[8 * hh + 2 * d + 1] += yai * w1; db[8 * hh + 2 * d] += ybi * w0; db[8 * hh + 2 * d + 1] += ybi * w1; } }
            asm volatile("" ::: "memory"); }
    }
#pragma unroll
    for (int c = 0; c < 16; ++c) { da[c] = wave_sum(da[c]); db[c] = wave_sum(db[c]); }
    if (lane == 0) {
#pragma unroll
        for (int q = 0; q < 4; ++q) { *(f32x4*)(aba + 4 * q) = (f32x4){da[4 * q], da[4 * q + 1], da[4 * q + 2], da[4 * q + 3]}; *(f32x4*)(abb + 4 * q) = (f32x4){db[4 * q], db[4 * q + 1], db[4 * q + 2], db[4 * q + 3]}; }
    }
}
__device__ __forceinline__ void ln_rows2_bf16in(const bf16* xa, const bf16* xb, const float* w, const float* b, bf16* oa, bf16* ob, unsigned char* qa8, unsigned char* qb8, float* sta, float* stb, int lane) {
    v4u ra[4], rb[4];
#pragma unroll
    for (int j = 0; j < 4; ++j) { ra[j] = ((const v4u*)xa)[lane + 64 * j]; rb[j] = ((const v4u*)xb)[lane + 64 * j]; }
    float va[32], vb[32];
#pragma unroll
    for (int j = 0; j < 4; ++j)
#pragma unroll
        for (int q = 0; q < 4; ++q) { va[8 * j + 2 * q] = bflo(ra[j][q]); va[8 * j + 2 * q + 1] = bfhi(ra[j][q]); vb[8 * j + 2 * q] = bflo(rb[j][q]); vb[8 * j + 2 * q + 1] = bfhi(rb[j][q]); }
    float sa = 0.f, sb = 0.f;
#pragma unroll
    for (int i = 0; i < 32; ++i) { sa += va[i]; sb += vb[i]; }
#pragma unroll
    for (int o = 1; o < 64; o <<= 1) { sa += __shfl_xor(sa, o); sb += __shfl_xor(sb, o); }
    const float ma = sa * (1.f / D), mb = sb * (1.f / D); float qa = 0.f, qb = 0.f;
#pragma unroll
    for (int i = 0; i < 32; ++i) { va[i] -= ma; vb[i] -= mb; qa += va[i] * va[i]; qb += vb[i] * vb[i]; }
#pragma unroll
    for (int o = 1; o < 64; o <<= 1) { qa += __shfl_xor(qa, o); qb += __shfl_xor(qb, o); }
    const float rsa = 1.f / sqrtf(qa * (1.f / D) + LN_EPS), rsb = 1.f / sqrtf(qb * (1.f / D) + LN_EPS);
#pragma unroll
    for (int j = 0; j < 4; ++j) { const float* wp = w + 8 * (lane + 64 * j); const float* bp = b + 8 * (lane + 64 * j);
        const f32x4 w0 = *(const f32x4*)wp, w1 = *(const f32x4*)(wp + 4), b0 = *(const f32x4*)bp, b1 = *(const f32x4*)(bp + 4);
        v4u o, p;
        o.x = pk2(va[8 * j] * rsa * w0.x + b0.x, va[8 * j + 1] * rsa * w0.y + b0.y); o.y = pk2(va[8 * j + 2] * rsa * w0.z + b0.z, va[8 * j + 3] * rsa * w0.w + b0.w);
        o.z = pk2(va[8 * j + 4] * rsa * w1.x + b1.x, va[8 * j + 5] * rsa * w1.y + b1.y); o.w = pk2(va[8 * j + 6] * rsa * w1.z + b1.z, va[8 * j + 7] * rsa * w1.w + b1.w);
        p.x = pk2(vb[8 * j] * rsb * w0.x + b0.x, vb[8 * j + 1] * rsb * w0.y + b0.y); p.y = pk2(vb[8 * j + 2] * rsb * w0.z + b0.z, vb[8 * j + 3] * rsb * w0.w + b0.w);
        p.z = pk2(vb[8 * j + 4] * rsb * w1.x + b1.x, vb[8 * j + 5] * rsb * w1.y + b1.y); p.w = pk2(vb[8 * j + 6] * rsb * w1.z + b1.z, vb[8 * j + 7] * rsb * w1.w + b1.w);
        ((v4u*)oa)[lane + 64 * j] = o; ((v4u*)ob)[lane + 64 * j] = p;
        float ya[8], yb[8];
        ya[0] = bflo(o.x); ya[1] = bfhi(o.x); ya[2] = bflo(o.y); ya[3] = bfhi(o.y); ya[4] = bflo(o.z); ya[5] = bfhi(o.z); ya[6] = bflo(o.w); ya[7] = bfhi(o.w);
        yb[0] = bflo(p.x); yb[1] = bfhi(p.x); yb[2] = bflo(p.y); yb[3] = bfhi(p.y); yb[4] = bflo(p.z); yb[5] = bfhi(p.z); yb[6] = bflo(p.w); yb[7] = bfhi(p.w);
        float ama = 0.f, amb = 0.f;
#pragma unroll
        for (int i = 0; i < 8; ++i) { ama = fmaxf(ama, fabsf(ya[i])); amb = fmaxf(amb, fabsf(yb[i])); }
#pragma unroll
        for (int o2 = 1; o2 < 32; o2 <<= 1) { ama = fmaxf(ama, __shfl_xor(ama, o2)); amb = fmaxf(amb, __shfl_xor(amb, o2)); }
        const float ia = ama > 0.f ? 119.f / ama : 0.f, ib = amb > 0.f ? 119.f / amb : 0.f;
        unsigned ha = 0u, la = 0u, hb = 0u, lb = 0u;
#pragma unroll
        for (int i = 0; i < 8; ++i) { const int sh = 8 * (i & 3) + 4 * (i >> 2);
            const int qa_ = (int)rintf(ya[i] * ia), qla = ((qa_ + 8) & 15) - 8, qha = (qa_ - qla) >> 4; ha |= (unsigned)(qha & 15) << sh; la |= (unsigned)(qla & 15) << sh;
            const int qb_ = (int)rintf(yb[i] * ib), qlb = ((qb_ + 8) & 15) - 8, qhb = (qb_ - qlb) >> 4; hb |= (unsigned)(qhb & 15) << sh; lb |= (unsigned)(qlb & 15) << sh; }
        ((unsigned*)qa8)[lane + 64 * j] = ha; ((unsigned*)qa8)[256 + lane + 64 * j] = la; ((unsigned*)qb8)[lane + 64 * j] = hb; ((unsigned*)qb8)[256 + lane + 64 * j] = lb;
        if ((lane & 31) == 0) { sta[2 * j + (lane >> 5)] = ama * (1.f / 119.f); stb[2 * j + (lane >> 5)] = amb * (1.f / 119.f); } }
}
__device__ __forceinline__ void p0_prologue(Frame& F, const float* x, const float* mem, const float* lnw, const float* lnb, const float* w_in, const float* lmw, const float* lmb, const float* w_kv, const float* w_out, const float* wq) {
    const int lane_ = fresh_lane(), tid_ = F.wave * 64 + lane_; (void)tid_;
    LAS float* scr = (LAS float*)(F.lds + F.wave * 16384);
    const int gw = F.vcu * NWAVES + F.wave, NGW = F.G * NWAVES;
    bf16* W1T = (bf16*)(F.ws + WS_W1T); bf16* WOT = (bf16*)(F.ws + WS_WOT); bf16* WQT = (bf16*)(F.ws + WS_WQT); bf16* XN = (bf16*)(F.ws + WS_XN);
    constexpr int I_1 = (D / 64) * ((IN_COLS + 31) / 32), I_KV = (D / 64) * (NKV / 32), I_O = (D / 64) * (D / 32), I_Q = I_O;
    constexpr int NITEMS = I_1 + I_KV; (void)I_O; (void)I_Q; (void)WOT; (void)WQT; (void)w_out; (void)wq;
#ifndef REP_P0T
#define REP_P0T 1
#endif
#ifndef REP_P0L
#define REP_P0L 1
#endif
    for (int rp_ = 0; rp_ < REP_P0T; ++rp_)
    for (int it = gw; it < NITEMS; it += NGW) {
        int r = it;
        if (r < I_1) { transpose_item<true>(w_in, D, IN_COLS, W1T, 0, scr, r, lane_); continue; } r -= I_1;
        transpose_item<false>(w_kv, D, NKV, W1T, N1, scr, r, lane_);
    }
    { v4u* z = (v4u*)(W1T + (size_t)6160 * D); const int n16 = 240 * D * 2 / 16; const v4u zero = {0u, 0u, 0u, 0u};
      for (int i = blockIdx.x * NTHREADS + tid_; i < n16; i += F.G * NTHREADS) z[i] = zero; }
    __syncthreads();
    for (int idx = tid_; idx < 8 * 8 * 64; idx += NTHREADS) { const int j = idx >> 9, q = (idx >> 6) & 7, ln = idx & 63; const int e = 4 * (ln + 64 * j) + (q >> 1);
        const float* src = w_in + (size_t)e * IN_COLS + 4096 + 8 * (q & 1); const f32x4 a = *(const f32x4*)src, b2 = *(const f32x4*)(src + 4);
        v4u o; o.x = pk2(a.x, a.y); o.y = pk2(a.z, a.w); o.z = pk2(b2.x, b2.y); o.w = pk2(b2.z, b2.w);
        *(LAS v4u*)(F.lds + (size_t)idx * 16) = o; }
    __syncthreads();
    float* ABp = (float*)(F.ws + WS_AB);
    for (int rp_ = 0; rp_ < REP_P0L; ++rp_)
    for (int m = gw; m < M; m += 2 * NGW) ln_rows2_bf16(x + (size_t)m * D, x + (size_t)(m + NGW) * D, lnw, lnb, XN + (size_t)m * D, XN + (size_t)(m + NGW) * D,
                                                        F.lds, ABp + (size_t)m * 16, ABp + (size_t)(m + NGW) * 16, lane_);
    for (int m = gw; m < BATCH * NMEM; m += NGW) ln_row_bf16(mem + (size_t)m * D, lmw, lmb, XN + (size_t)(M + m) * D, lane_);
}

struct Sched1 {
    pg8::StaticOrder so;
    __device__ void init(int G_, int c_) { so.init(M, PROJ_LD, G_, c_); }
    __device__ bool next(int i, pg8::Unit& u) const { return so.next(i, u); }
    __device__ __forceinline__ void a_ready(const pg8::Unit&) const {}
    __device__ __forceinline__ void done(const pg8::Unit&) const {}
};
struct SchedKV {
    int e;
    __device__ bool next(int i, pg8::Unit& u) const { if (i) return false; u.pm = 64 + (e >> 2); u.pn = 25 + (e & 3); return true; }
    __device__ __forceinline__ void a_ready(const pg8::Unit&) const {}
    __device__ __forceinline__ void done(const pg8::Unit&) const {}
};
struct Epi1 {
    static constexpr bool PERM = true, AFTER_DRAIN = false;
    bf16* PROJ; float* AB; bf16* MKV; const float* gnw;
    __device__ __forceinline__ void operator()(const pg8::f32x4 (&acc)[2][2][4][2], const pg8::Unit& u, int wr, int wc, int fr, int fq) const {
        const int rloc = wr * 64 + fr, cloc = wc * 32 + 8 * fq;
        if (u.pm < 64 && u.pn == 24) {
            return;
        }
        bf16* base; int ld;
        if (u.pm < 64) { base = PROJ + (size_t)u.pm * 256 * PROJ_LD + u.pn * 256; ld = PROJ_LD; }
        else { base = MKV + (size_t)(u.pm - 64) * 256 * NKV + (u.pn - 25) * 256; ld = NKV; }
        base += (size_t)rloc * ld + cloc;
        const bool zt = u.pm < 64 && u.pn >= 12 && u.pn < 16;
        pg8::f32x4 gw0 = {1.f, 1.f, 1.f, 1.f}, gw1 = gw0;
        if (zt) { gw0 = *(const pg8::f32x4*)(gnw + cloc); gw1 = *(const pg8::f32x4*)(gnw + cloc + 4); }
#pragma unroll
        for (int ai = 0; ai < 2; ++ai)
#pragma unroll
            for (int m = 0; m < 4; ++m) { bf16* rowp = base + (size_t)(ai * 128 + m * 16) * ld;
#pragma unroll
                for (int bj = 0; bj < 2; ++bj) { pg8::f32x4 v0 = acc[ai][bj][m][0], v1 = acc[ai][bj][m][1];
                    if (zt) {
#pragma unroll
                        for (int i = 0; i < 4; ++i) { v0[i] = silu_f(v0[i]) * gw0[i]; v1[i] = silu_f(v1[i]) * gw1[i]; } }
                    pg8::u32x4 w; w.x = pg8::cvt_pk_bf16(v0[0], v0[1]); w.y = pg8::cvt_pk_bf16(v0[2], v0[3]); w.z = pg8::cvt_pk_bf16(v1[0], v1[1]); w.w = pg8::cvt_pk_bf16(v1[2], v1[3]);
                    *(pg8::u32x4*)(rowp + bj * 128) = w; } }
    }
};

constexpr int MK_STRIDE = 272;
typedef short bf16x8 __attribute__((ext_vector_type(8)));
typedef short s16x4 __attribute__((ext_vector_type(4)));
typedef float f32x16 __attribute__((ext_vector_type(16)));
#define MFMA32(a, b, c) __builtin_amdgcn_mfma_f32_32x32x16_bf16((a), (b), (c), 0, 0, 0)
__device__ __forceinline__ int crow(int r, int h) { return (r & 3) + 8 * (r >> 2) + 4 * h; }
template <int S> __device__ __forceinline__ bf16x8 pack8(const f32x16& x) {
    v4u p; p.x = cvtpk(x[8 * S], x[8 * S + 1]); p.y = cvtpk(x[8 * S + 2], x[8 * S + 3]); p.z = cvtpk(x[8 * S + 4], x[8 * S + 5]); p.w = cvtpk(x[8 * S + 6], x[8 * S + 7]);
    return __builtin_bit_cast(bf16x8, p);
}
template <int S> __device__ __forceinline__ void pack8_hilo(const f32x16& x, bf16x8& hi, bf16x8& lo) {
    v4u ph, pl;
#pragma unroll
    for (int i = 0; i < 4; ++i) { const float a = x[8 * S + 2 * i], b = x[8 * S + 2 * i + 1]; const unsigned w = cvtpk(a, b); ph[i] = w; pl[i] = cvtpk(a - bflo(w), b - bfhi(w)); }
    hi = __builtin_bit_cast(bf16x8, ph); lo = __builtin_bit_cast(bf16x8, pl);
}
typedef short v4i16_t __attribute__((ext_vector_type(4)));
__device__ __forceinline__ s16x4 tr_read(const LAS unsigned char* p) { return __builtin_bit_cast(s16x4, __builtin_amdgcn_ds_read_tr16_b64_v4i16((LAS v4i16_t*)p)); }
__device__ __forceinline__ bf16x8 cat8(s16x4 lo, s16x4 hi) { return __builtin_shufflevector(lo, hi, 0, 1, 2, 3, 4, 5, 6, 7); }

constexpr int UROW = 1152;
constexpr int OPS_CHUNK = 65536, OPS_W = 0, OPS_U = 16384, OPS_Q = 32768, OPS_K = 49152, QKF_CHUNK = 8192;
constexpr int PR_K = 0, PR_Q = 17408, PR_V = 34816, PR_A = 51200, PR_GC = 67584, PR_HALF = 68608;
__device__ __forceinline__ void prep_tile(int which, int ti, int tj, const LAS unsigned char* Kl, const LAS unsigned char* Ql, LAS float* Am, const LAS float* gcl, const LAS float* betl,
                                          unsigned char* qkf, int lane, int c, int h) {
    const bool zero_tile = which ? (ti == 1 && tj == 0) : (ti == 0 && tj == 1);
    f32x16 acc;
#pragma unroll
    for (int r = 0; r < 16; ++r) acc[r] = 0.f;
    if (!zero_tile) {
        const LAS unsigned char* Bl = which ? Ql : Kl;
#pragma unroll
        for (int ks = 0; ks < 8; ++ks) {
            const bf16x8 af = *(const LAS bf16x8*)(Kl + (32 * ti + c) * MK_STRIDE + (16 * ks + 8 * h) * 2);
            const bf16x8 bf = *(const LAS bf16x8*)(Bl + (32 * tj + c) * MK_STRIDE + (16 * ks + 8 * h) * 2);
            acc = MFMA32(af, bf, acc);
        }
    }
    const int col = 32 * tj + c; const float gcol = gcl[col];
    if (which == 0) {
        if (!zero_tile) {
#pragma unroll
            for (int r = 0; r < 16; ++r) { const int i = 32 * ti + crow(r, h);
                Am[i * 64 + col] = (col < i) ? betl[i] * acc[r] * __expf(gcl[i] - gcol) : 0.f; }
        }
    } else {
#pragma unroll
        for (int r = 0; r < 16; ++r) { const int jj = 32 * ti + crow(r, h);
            acc[r] = (jj <= col) ? acc[r] * __expf(gcol - gcl[jj]) : 0.f; }
        *(bf16x8*)(qkf + (((tj * 2 + ti) * 2 + 0) * 64 + lane) * 16) = pack8<0>(acc);
        *(bf16x8*)(qkf + (((tj * 2 + ti) * 2 + 1) * 64 + lane) * 16) = pack8<1>(acc);
    }
}
template <bool ISW> __device__ __forceinline__ void prep_subst(float (&X)[64], const LAS float* Amz, const LAS float* bz, const LAS float* ez, const LAS unsigned char* Rb, const int rstride) {
#pragma unroll
    for (int i = 0; i < 64; ++i) {
        const float sc = ISW ? bz[i] * ez[i] : bz[i];
        float a0 = sc * bf2f(*(const LAS bf16*)(Rb + i * rstride)), a1 = 0.f, a2 = 0.f, a3 = 0.f;
#pragma unroll
        for (int j4 = 0; j4 < (i + 3) / 4; ++j4) { const f32x4 a4 = *(const LAS f32x4*)(Amz + i * 64 + 4 * j4);
            if (4 * j4 < i) a0 -= a4.x * X[4 * j4];
            if (4 * j4 + 1 < i) a1 -= a4.y * X[4 * j4 + 1];
            if (4 * j4 + 2 < i) a2 -= a4.z * X[4 * j4 + 2];
            if (4 * j4 + 3 < i) a3 -= a4.w * X[4 * j4 + 3]; }
        X[i] = (a0 + a1) + (a2 + a3);
        if ((i & 1) == 1) asm volatile("" : "+v"(X[i]) :: "memory");
    }
}
__device__ __forceinline__ void gdn_prep_pair(Frame& F, int pair, const float* cw, const float* a_log, const float* dt_bias) {
    const int lane = fresh_lane(), wave = F.wave, gq = wave >> 2, lw = wave & 3, ltid = lw * 64 + lane, c = lane & 31, h = lane >> 5;
    const int unit = 2 * pair + gq;
    const int n = unit & 63, bh = unit >> 6, b = bh >> 3, hd = bh & 7;
    const bf16* PROJ = (const bf16*)(F.ws + WS_PROJ); const float* AB = (const float*)(F.ws + WS_AB);
    unsigned char* ops = (unsigned char*)F.out + (size_t)unit * OPS_CHUNK; unsigned char* qkf = F.ws + WS_QKF + (size_t)unit * QKF_CHUNK; float* GL = (float*)(F.ws + WS_GL);
    LAS unsigned char* L0 = F.lds + gq * PR_HALF;
    LAS unsigned char* Kl = L0 + PR_K; LAS unsigned char* Ql = L0 + PR_Q; LAS unsigned char* Vl = L0 + PR_V; LAS float* Am = (LAS float*)(L0 + PR_A);
    LAS float* gcl = (LAS float*)(L0 + PR_GC); LAS float* betl = gcl + 64; LAS float* egl = gcl + 128;
    const size_t row0 = (size_t)b * SEQ + 64 * n; const int t0 = 64 * n;
    __syncthreads();
    if (lw == 0) {
        const float a = AB[(row0 + lane) * 16 + hd], bb = AB[(row0 + lane) * 16 + 8 + hd];
        float g = -__expf(a_log[hd]) * softplus_f(a + dt_bias[hd]);
#pragma unroll
        for (int o = 1; o < 64; o <<= 1) { const float t = __shfl_up(g, o); if (lane >= o) g += t; }
        gcl[lane] = g; betl[lane] = sigmoid_f(bb); egl[lane] = __expf(g);
    }
    float y[3][16][2];
#pragma unroll
    for (int p = 0; p < 3; ++p) {
        const int ch = p * 1024 + hd * 128 + 2 * lane;
        float w0[4], w1[4];
#pragma unroll
        for (int i = 0; i < 4; ++i) { w0[i] = cw[i * QKV_LD + ch]; w1[i] = cw[i * QKV_LD + ch + 1]; }
        float x0[19], x1[19];
#pragma unroll
        for (int j = 0; j < 19; ++j) { const int tt = t0 + 16 * lw - 3 + j;
            unsigned x2 = 0u; if (tt >= 0) x2 = *(const unsigned*)(PROJ + (row0 + 16 * lw - 3 + j) * PROJ_LD + ch);
            x0[j] = bflo(x2); x1[j] = bfhi(x2); }
#pragma unroll
        for (int r = 0; r < 16; ++r) { float a0 = 0.f, a1 = 0.f;
#pragma unroll
            for (int i = 0; i < 4; ++i) { a0 += w0[i] * x0[r + i]; a1 += w1[i] * x1[r + i]; }
            y[p][r][0] = silu_f(a0); y[p][r][1] = silu_f(a1); }
    }
    {
        float ssq[32];
#pragma unroll
        for (int r = 0; r < 16; ++r) { ssq[r] = y[0][r][0] * y[0][r][0] + y[0][r][1] * y[0][r][1]; ssq[16 + r] = y[1][r][0] * y[1][r][0] + y[1][r][1] * y[1][r][1]; }
#pragma unroll
        for (int o = 1; o < 64; o <<= 1) {
#pragma unroll
            for (int r = 0; r < 32; ++r) ssq[r] += __shfl_xor(ssq[r], o); }
#pragma unroll
        for (int r = 0; r < 16; ++r) { const float qs = rsqrtf(ssq[r] + RMS_EPS) * 0.08838834764831845f, ks = rsqrtf(ssq[16 + r] + RMS_EPS);
            y[0][r][0] *= qs; y[0][r][1] *= qs; y[1][r][0] *= ks; y[1][r][1] *= ks; }
    }
    __syncthreads();
    const float glast = gcl[63];
#pragma unroll
    for (int r = 0; r < 16; ++r) {
        const int i = 16 * lw + r; const float eg = egl[i], gi = gcl[i];
        *(LAS unsigned*)(Ql + i * MK_STRIDE + 4 * lane) = pk2(y[0][r][0], y[0][r][1]);
        *(LAS unsigned*)(Kl + i * MK_STRIDE + 4 * lane) = pk2(y[1][r][0], y[1][r][1]);
        *(LAS unsigned*)(Vl + i * 256 + 4 * lane) = pk2(y[2][r][0], y[2][r][1]);
        const float ek = __expf(glast - gi);
        *(unsigned*)(ops + OPS_Q + i * 256 + 4 * lane) = pk2(y[0][r][0] * eg, y[0][r][1] * eg);
        *(unsigned*)(ops + OPS_K + i * 256 + 4 * lane) = pk2(y[1][r][0] * ek, y[1][r][1] * ek);
    }
    if (ltid == 0) GL[unit] = __expf(glast);
    __syncthreads();
    if (lw == 0) { prep_tile(0, 0, 0, Kl, Ql, Am, gcl, betl, qkf, lane, c, h); prep_tile(0, 1, 1, Kl, Ql, Am, gcl, betl, qkf, lane, c, h); }
    else if (lw == 1) { prep_tile(0, 1, 0, Kl, Ql, Am, gcl, betl, qkf, lane, c, h); prep_tile(1, 0, 0, Kl, Ql, Am, gcl, betl, qkf, lane, c, h); }
    else if (lw == 2) { prep_tile(1, 0, 1, Kl, Ql, Am, gcl, betl, qkf, lane, c, h); prep_tile(1, 1, 1, Kl, Ql, Am, gcl, betl, qkf, lane, c, h); }
    else { prep_tile(1, 1, 0, Kl, Ql, Am, gcl, betl, qkf, lane, c, h); }
    __syncthreads();
    {
        const int cc = ltid & 127; const bool isw = lw >= 2;
        int zl = 0; asm volatile("" : "+v"(zl));
        const LAS float* Amz = Am + zl; const LAS float* bz = betl + zl; const LAS float* ez = egl + zl;
        float X[64];
        if (isw) prep_subst<true>(X, Amz, bz, ez, Kl + 2 * cc, MK_STRIDE); else prep_subst<false>(X, Amz, bz, ez, Vl + 2 * cc, 256);
        if (!isw) {
            const int sl = cc >> 5, c_ = cc & 31;
#pragma unroll
            for (int h_ = 0; h_ < 2; ++h_) {
                unsigned wds[16];
#pragma unroll
                for (int rt = 0; rt < 2; ++rt)
#pragma unroll
                    for (int rp = 0; rp < 8; ++rp) { const int r0 = 2 * rp, r1 = 2 * rp + 1;
                        wds[rt * 8 + rp] = pk2(X[32 * rt + (r0 & 3) + 8 * (r0 >> 2) + 4 * h_], X[32 * rt + (r1 & 3) + 8 * (r1 >> 2) + 4 * h_]); }
                v4u* dst = (v4u*)(ops + OPS_U + ((sl * 64 + c_ + 32 * h_) * 64));
#pragma unroll
                for (int q = 0; q < 4; ++q) { v4u o; o.x = wds[4 * q]; o.y = wds[4 * q + 1]; o.z = wds[4 * q + 2]; o.w = wds[4 * q + 3]; dst[q] = o; }
            }
        } else {
#pragma unroll
            for (int i = 0; i < 64; ++i) *(bf16*)(ops + OPS_W + i * 256 + 2 * cc) = (bf16)f2bf(-X[i]);
        }
    }
}

constexpr int SC_W = 0, SC_Q = 16896, SC_K = 33792, SC_QKF = 54272, SC_BUF = 62464, SC_OBUF = 2 * SC_BUF, SC_OSTRIDE = 272, SC_OBYTES = 64 * SC_OSTRIDE;
__device__ __forceinline__ void gdn_scan_unit(Frame& F, int bh, const float* gnw) {
    const int lane = fresh_lane(), wave = F.wave, c = lane & 31, h = lane >> 5;
    const int b = bh >> 3, hd = bh & 7;
    const bf16* PROJ = (const bf16*)(F.ws + WS_PROJ); bf16* OMIX = (bf16*)(F.ws + WS_OMIX);
    const unsigned char* ops0 = (unsigned char*)F.out + (size_t)bh * 64 * OPS_CHUNK; const unsigned char* qkf0 = F.ws + WS_QKF + (size_t)bh * 64 * QKF_CHUNK; const float* GL = (const float*)(F.ws + WS_GL) + bh * 64;
    const size_t rowb = (size_t)b * SEQ;
    __syncthreads();
    if (wave >= 4) {
        const int lw = wave - 4;
        const int r4 = lane >> 4, c8 = lane & 15;
        (void)gnw;
        v4u a0[4], q0[4], k0[4], f0[2], a1[4], q1[4], k1[4], f1[2];
        v4u zA[4], zB[4];
#define LD_ISSUE(A, Q, K, Fq, nn) do { if ((nn) < 64) { const int ltid = lw * 64 + fresh_lane(); const unsigned char* src_ = ops0 + (size_t)(nn) * OPS_CHUNK; \
            _Pragma("unroll") for (int k_ = 0; k_ < 4; ++k_) { const int i_ = ltid + 256 * k_; A[k_] = *(const v4u*)(src_ + OPS_W + i_ * 16); Q[k_] = *(const v4u*)(src_ + OPS_Q + i_ * 16); K[k_] = *(const v4u*)(src_ + OPS_K + i_ * 16); } \
            _Pragma("unroll") for (int k_ = 0; k_ < 2; ++k_) Fq[k_] = *(const v4u*)(qkf0 + (size_t)(nn) * QKF_CHUNK + (ltid + 256 * k_) * 16); } } while (0)
#define LD_STORE(A, Q, K, Fq, nn) do { if ((nn) < 64) { const int ltid = lw * 64 + fresh_lane(); LAS unsigned char* dst_ = F.lds + ((nn) & 1) * SC_BUF; \
            _Pragma("unroll") for (int k_ = 0; k_ < 4; ++k_) { const int i_ = ltid + 256 * k_, r_ = i_ >> 4, ch_ = i_ & 15; \
                *(LAS v2u*)(dst_ + SC_W + r_ * 264 + ch_ * 16) = (v2u){A[k_].x, A[k_].y}; *(LAS v2u*)(dst_ + SC_W + r_ * 264 + ch_ * 16 + 8) = (v2u){A[k_].z, A[k_].w}; \
                *(LAS v2u*)(dst_ + SC_Q + r_ * 264 + ch_ * 16) = (v2u){Q[k_].x, Q[k_].y}; *(LAS v2u*)(dst_ + SC_Q + r_ * 264 + ch_ * 16 + 8) = (v2u){Q[k_].z, Q[k_].w}; \
                *(LAS v4u*)(dst_ + SC_K + r_ * 320 + ch_ * 16) = K[k_]; } \
            _Pragma("unroll") for (int k_ = 0; k_ < 2; ++k_) *(LAS v4u*)(dst_ + SC_QKF + (ltid + 256 * k_) * 16) = Fq[k_]; } } while (0)
#define Z_ISSUE(Z, mm) do { const size_t rowc_ = rowb + 64 * (mm) + 16 * lw + r4; \
            _Pragma("unroll") for (int g = 0; g < 4; ++g) Z[g] = *(const v4u*)(PROJ + (rowc_ + 4 * g) * PROJ_LD + 3072 + hd * 128 + 8 * c8); } while (0)
#define FINISH(mm, Z) do { const LAS unsigned char* ob = F.lds + SC_OBUF + ((mm) & 1) * SC_OBYTES; const size_t rowc_ = rowb + 64 * (mm) + 16 * lw + r4; \
            _Pragma("unroll") for (int g = 0; g < 4; ++g) { const v4u w = *(const LAS v4u*)(ob + (16 * lw + 4 * g + r4) * SC_OSTRIDE + 16 * c8); \
                float ov[8]; ov[0] = bflo(w.x); ov[1] = bfhi(w.x); ov[2] = bflo(w.y); ov[3] = bfhi(w.y); ov[4] = bflo(w.z); ov[5] = bfhi(w.z); ov[6] = bflo(w.w); ov[7] = bfhi(w.w); \
                float ss = 0.f; _Pragma("unroll") for (int e = 0; e < 8; ++e) ss += ov[e] * ov[e]; \
                ss += __shfl_xor(ss, 1); ss += __shfl_xor(ss, 2); ss += __shfl_xor(ss, 4); ss += __shfl_xor(ss, 8); \
                const float rinv = rsqrtf(ss * (1.f / HD) + RMS_EPS); const v4u zz = Z[g]; \
                float zf[8]; zf[0] = bflo(zz.x); zf[1] = bfhi(zz.x); zf[2] = bflo(zz.y); zf[3] = bfhi(zz.y); zf[4] = bflo(zz.z); zf[5] = bfhi(zz.z); zf[6] = bflo(zz.w); zf[7] = bfhi(zz.w); \
                v4u ow; ow.x = pk2(ov[0] * rinv * zf[0], ov[1] * rinv * zf[1]); ow.y = pk2(ov[2] * rinv * zf[2], ov[3] * rinv * zf[3]); \
                ow.z = pk2(ov[4] * rinv * zf[4], ov[5] * rinv * zf[5]); ow.w = pk2(ov[6] * rinv * zf[6], ov[7] * rinv * zf[7]); \
                *(v4u*)(OMIX + (rowc_ + 4 * g) * D + hd * 128 + 8 * c8) = ow; } } while (0)
#define SC_ITER(nn, SA, SQ, SK, SF, IA, IQ, IK, IF, ZI, ZU) do { LD_STORE(SA, SQ, SK, SF, (nn) + 1); LD_ISSUE(IA, IQ, IK, IF, (nn) + 2); Z_ISSUE(ZI, (nn)); \
            if ((nn) >= 1) FINISH((nn) - 1, ZU); __syncthreads(); } while (0)
        LD_ISSUE(a0, q0, k0, f0, 0); LD_STORE(a0, q0, k0, f0, 0); LD_ISSUE(a1, q1, k1, f1, 1);
        __syncthreads();
        for (int n = 0; n < 64; n += 2) {
            SC_ITER(n, a1, q1, k1, f1, a0, q0, k0, f0, zA, zB);
            SC_ITER(n + 1, a0, q0, k0, f0, a1, q1, k1, f1, zB, zA);
        }
        FINISH(63, zB);
#undef SC_ITER
#undef FINISH
#undef Z_ISSUE
#undef LD_STORE
#undef LD_ISSUE
    } else {
        __builtin_amdgcn_s_setprio(3);
        f32x16 S[4];
#pragma unroll
        for (int d = 0; d < 4; ++d)
#pragma unroll
            for (int r = 0; r < 16; ++r) S[d][r] = 0.f;
        v4u un[4]; float gl_n;
        { const v4u* up = (const v4u*)(ops0 + OPS_U + (wave * 64 + lane) * 64);
#pragma unroll
          for (int q = 0; q < 4; ++q) un[q] = up[q];
          gl_n = GL[0]; }
        __syncthreads();
        for (int n = 0; n < 64; ++n) {
            const LAS unsigned char* B_ = F.lds + (n & 1) * SC_BUF;
            LAS unsigned char* ob = F.lds + SC_OBUF + (n & 1) * SC_OBYTES;
            f32x16 vn[2]; const float gl = gl_n;
#pragma unroll
            for (int rt = 0; rt < 2; ++rt)
#pragma unroll
                for (int rp = 0; rp < 8; ++rp) { const unsigned w = un[(rt * 8 + rp) >> 2][(rt * 8 + rp) & 3]; vn[rt][2 * rp] = bflo(w); vn[rt][2 * rp + 1] = bfhi(w); }
            if (n + 1 < 64) { const v4u* up = (const v4u*)(ops0 + (size_t)(n + 1) * OPS_CHUNK + OPS_U + (wave * 64 + lane) * 64);
#pragma unroll
                for (int q = 0; q < 4; ++q) un[q] = up[q];
                gl_n = GL[n + 1]; }
            f32x16 o[2];
#pragma unroll
            for (int rt = 0; rt < 2; ++rt)
#pragma unroll
                for (int r = 0; r < 16; ++r) o[rt][r] = 0.f;
            const LAS unsigned char* wp = B_ + SC_W + c * 264 + 8 * h; const LAS unsigned char* qp = B_ + SC_Q + c * 264 + 8 * h;
#define SC_KSTEP(ks) do { const bf16x8 sf_ = pack8<(ks) & 1>(S[(ks) >> 1]); \
                _Pragma("unroll") for (int rt = 0; rt < 2; ++rt) { \
                    const s16x4 w0 = *(const LAS s16x4*)(wp + rt * 32 * 264 + 32 * (ks)), w1 = *(const LAS s16x4*)(wp + rt * 32 * 264 + 32 * (ks) + 16); \
                    vn[rt] = MFMA32(cat8(w0, w1), sf_, vn[rt]); \
                    const s16x4 q0 = *(const LAS s16x4*)(qp + rt * 32 * 264 + 32 * (ks)), q1 = *(const LAS s16x4*)(qp + rt * 32 * 264 + 32 * (ks) + 16); \
                    o[rt] = MFMA32(cat8(q0, q1), sf_, o[rt]); } } while (0)
            SC_KSTEP(0); SC_KSTEP(1); SC_KSTEP(2); SC_KSTEP(3);
            SC_KSTEP(4); SC_KSTEP(5); SC_KSTEP(6); SC_KSTEP(7); __builtin_amdgcn_sched_barrier(0);
#undef SC_KSTEP
            bf16x8 vf[4]; vf[0] = pack8<0>(vn[0]); vf[1] = pack8<1>(vn[0]); vf[2] = pack8<0>(vn[1]); vf[3] = pack8<1>(vn[1]);
#pragma unroll
            for (int to = 0; to < 2; ++to)
#pragma unroll
                for (int kk = 0; kk < 4; ++kk) {
                    const bf16x8 qa = *(const LAS bf16x8*)(B_ + SC_QKF + ((((to * 2 + (kk >> 1)) * 2 + (kk & 1)) * 64 + lane) * 16));
                    o[to] = MFMA32(qa, vf[kk], o[to]);
                }
#pragma unroll
            for (int rt = 0; rt < 2; ++rt)
#pragma unroll
                for (int r = 0; r < 16; ++r) *(LAS bf16*)(ob + (32 * rt + crow(r, h)) * SC_OSTRIDE + (32 * wave + c) * 2) = (bf16)f2bf(o[rt][r]);
            __builtin_amdgcn_sched_barrier(0);
            const LAS unsigned char* kb = B_ + SC_K + (4 * h + ((lane & 15) >> 2)) * 320 + (((lane >> 4) & 1) * 16 + (lane & 3) * 4) * 2;
#pragma unroll
            for (int dt = 0; dt < 4; ++dt) {
#pragma unroll
                for (int r = 0; r < 16; ++r) S[dt][r] *= gl;
#pragma unroll
                for (int kk = 0; kk < 4; ++kk) {
                    const s16x4 lo = tr_read(kb + (16 * kk) * 320 + dt * 64), hi = tr_read(kb + (16 * kk + 8) * 320 + dt * 64);
                    S[dt] = MFMA32(cat8(lo, hi), vf[kk], S[dt]);
                }
            }
            __syncthreads();
        }
        __builtin_amdgcn_s_setprio(0);
    }
}

constexpr int SBK_STRIDE = 272, SBV_STRIDE = 320, SB_KBYTES = 64 * SBK_STRIDE, SB_VBYTES = 64 * SBV_STRIDE, SB_BUF = SB_KBYTES + SB_VBYTES, SB_FLAGS_OFF = 2 * SB_BUF;
__device__ __forceinline__ void sb_unit(Frame& F, int unit, const float* sb_norm_w) {
    const int lane_ = fresh_lane(), tid_ = F.wave * 64 + lane_; (void)tid_;
    const int qb = unit & 15, bh = unit >> 4, b = bh >> 2, hh = bh & 3;
    const int tid = tid_, lane = lane_, wave = F.wave, c = lane & 31, h = lane >> 5;
    const bf16* PROJ = (const bf16*)(F.ws + WS_PROJ); bf16* OMIX = (bf16*)(F.ws + WS_OMIX);
    const size_t rowb = (size_t)b * SEQ;
    const bf16* Qp = PROJ + 4096 + hh * 128; const bf16* Kp = Qp + 512; const bf16* Vp = Qp + 1024;
    const int q0w = qb * 256 + wave * 32;
    bf16x8 qf[8];
#pragma unroll
    for (int ks = 0; ks < 8; ++ks) qf[ks] = *(const bf16x8*)(Qp + (rowb + q0w + c) * PROJ_LD + 16 * ks + 8 * h);
    bf16x8 U0, U1, ONES;
#pragma unroll
    for (int j = 0; j < 8; ++j) { const int jin = 8 * (j >> 2) + 4 * h + (j & 3); U0[j] = (jin > c) ? (short)0x3F80 : (short)0; U1[j] = (16 + jin > c) ? (short)0x3F80 : (short)0; ONES[j] = (short)0x3F80; }
    f32x16 o[4];
#pragma unroll
    for (int d = 0; d < 4; ++d)
#pragma unroll
        for (int r = 0; r < 16; ++r) o[d][r] = 0.f;
    float carry = 0.f; bool wdone = false;
    LAS volatile int* flags = (LAS volatile int*)(F.lds + SB_FLAGS_OFF);
    const int kt0 = 4 * qb + 3;
    const int srow0 = tid >> 4, sch = tid & 15;
    v4u kr[2], vr[2];
#define SB_LOAD(kt) do { _Pragma("unroll") for (int i_ = 0; i_ < 2; ++i_) { const size_t go = (rowb + 64 * (kt) + srow0 + 32 * i_) * PROJ_LD + 8 * sch; kr[i_] = *(const v4u*)(Kp + go); vr[i_] = *(const v4u*)(Vp + go); } } while (0)
#define SB_STORE(buf) do { _Pragma("unroll") for (int i_ = 0; i_ < 2; ++i_) { *(LAS v4u*)(F.lds + (buf) * SB_BUF + (srow0 + 32 * i_) * SBK_STRIDE + 16 * sch) = kr[i_]; *(LAS v4u*)(F.lds + (buf) * SB_BUF + SB_KBYTES + (srow0 + 32 * i_) * SBV_STRIDE + 16 * sch) = vr[i_]; } } while (0)
    __syncthreads();
    SB_LOAD(kt0); SB_STORE(0);
    __syncthreads();
    for (int it = 0;; ++it) {
        const int kt = kt0 - it, buf = it & 1;
        if (kt > 0) SB_LOAD(kt - 1);
        const bool active = !wdone && (64 * kt <= q0w + 30);
        if (active) {
            const LAS unsigned char* Kt = F.lds + buf * SB_BUF; const LAS unsigned char* Vt = Kt + SB_KBYTES;
            const int qg = q0w + c, kbase = 64 * kt + 4 * h;
            f32x16 cb;
#pragma unroll
            for (int r = 0; r < 16; ++r) cb[r] = carry;
            bf16x8 pa[4];
            f32x16 T1;
            {
                f32x16 p1;
#pragma unroll
                for (int r = 0; r < 16; ++r) p1[r] = 0.f;
#pragma unroll
                for (int ks = 0; ks < 8; ++ks) p1 = MFMA32(*(const LAS bf16x8*)(Kt + (c + 32) * SBK_STRIDE + (16 * ks + 8 * h) * 2), qf[ks], p1);
                f32x16 l1;
#pragma unroll
                for (int r = 0; r < 16; ++r) { const int key = kbase + 32 + (r & 3) + 8 * (r >> 2); const float z = p1[r] * 0.08838834764831845f;
                    const float e = __expf(z); const float sp = z > 20.f ? z : __logf(1.f + e); l1[r] = (key < qg) ? -sp : 0.f; p1[r] = z - sp; }
                bf16x8 Lh0, Ll0, Lh1, Ll1; pack8_hilo<0>(l1, Lh0, Ll0); pack8_hilo<1>(l1, Lh1, Ll1);
                T1 = MFMA32(ONES, Lh0, cb); T1 = MFMA32(ONES, Ll0, T1); T1 = MFMA32(ONES, Lh1, T1); T1 = MFMA32(ONES, Ll1, T1);
                f32x16 A1 = MFMA32(U0, Lh0, cb); A1 = MFMA32(U0, Ll0, A1); A1 = MFMA32(U1, Lh1, A1); A1 = MFMA32(U1, Ll1, A1);
#pragma unroll
                for (int r = 0; r < 16; ++r) { const int key = kbase + 32 + (r & 3) + 8 * (r >> 2); p1[r] = (key < qg) ? __expf(p1[r] + A1[r]) : 0.f; }
                pa[2] = pack8<0>(p1); pa[3] = pack8<1>(p1);
            }
            {
                f32x16 p0;
#pragma unroll
                for (int r = 0; r < 16; ++r) p0[r] = 0.f;
#pragma unroll
                for (int ks = 0; ks < 8; ++ks) p0 = MFMA32(*(const LAS bf16x8*)(Kt + c * SBK_STRIDE + (16 * ks + 8 * h) * 2), qf[ks], p0);
                f32x16 l0;
#pragma unroll
                for (int r = 0; r < 16; ++r) { const int key = kbase + (r & 3) + 8 * (r >> 2); const float z = p0[r] * 0.08838834764831845f;
                    const float e = __expf(z); const float sp = z > 20.f ? z : __logf(1.f + e); l0[r] = (key < qg) ? -sp : 0.f; p0[r] = z - sp; }
                bf16x8 Lh0, Ll0, Lh1, Ll1; pack8_hilo<0>(l0, Lh0, Ll0); pack8_hilo<1>(l0, Lh1, Ll1);
                f32x16 A0 = MFMA32(U0, Lh0, T1); A0 = MFMA32(U0, Ll0, A0); A0 = MFMA32(U1, Lh1, A0); A0 = MFMA32(U1, Ll1, A0);
                T1 = MFMA32(ONES, Lh0, T1); T1 = MFMA32(ONES, Ll0, T1); T1 = MFMA32(ONES, Lh1, T1); T1 = MFMA32(ONES, Ll1, T1);
                carry = T1[0];
#pragma unroll
                for (int r = 0; r < 16; ++r) { const int key = kbase + (r & 3) + 8 * (r >> 2); p0[r] = (key < qg) ? __expf(p0[r] + A0[r]) : 0.f; }
                pa[0] = pack8<0>(p0); pa[1] = pack8<1>(p0);
            }
            const LAS unsigned char* vb = Vt + (4 * h + ((lane & 15) >> 2)) * SBV_STRIDE + (((lane >> 4) & 1) * 16 + (lane & 3) * 4) * 2;
#pragma unroll
            for (int dt = 0; dt < 4; ++dt)
#pragma unroll
                for (int kv = 0; kv < 4; ++kv) {
                    const s16x4 lo = tr_read(vb + (16 * kv) * SBV_STRIDE + dt * 64), hi = tr_read(vb + (16 * kv + 8) * SBV_STRIDE + dt * 64);
                    o[dt] = MFMA32(pa[kv], cat8(lo, hi), o[dt]);
                }
            wdone = __all(carry < -30.f);
        }
        if (lane == 0) flags[buf * 8 + wave] = wdone ? 1 : 0;
        if (kt > 0) SB_STORE(buf ^ 1);
        __syncthreads();
        if (kt == 0) break;
        int alld = 1;
#pragma unroll
        for (int w = 0; w < 8; ++w) alld &= flags[buf * 8 + w];
        if (alld) break;
    }
#undef SB_LOAD
#undef SB_STORE
    float rinv[16];
#pragma unroll
    for (int r = 0; r < 16; ++r) { float ss = o[0][r] * o[0][r] + o[1][r] * o[1][r] + o[2][r] * o[2][r] + o[3][r] * o[3][r];
        ss += __shfl_xor(ss, 1); ss += __shfl_xor(ss, 2); ss += __shfl_xor(ss, 4); ss += __shfl_xor(ss, 8); ss += __shfl_xor(ss, 16);
        rinv[r] = rsqrtf(ss * (1.f / HD) + RMS_EPS); }
#pragma unroll
    for (int dt = 0; dt < 4; ++dt) { const float nw = sb_norm_w[hh * 128 + 32 * dt + c];
#pragma unroll
        for (int r = 0; r < 16; ++r) OMIX[(rowb + q0w + crow(r, h)) * D + 1024 + hh * 128 + 32 * dt + c] = (bf16)f2bf(o[dt][r] * rinv[r] * nw); }
}

constexpr int MEM_KBYTES = 256 * SBK_STRIDE, MEM_VBYTES = 256 * SBV_STRIDE, MEM_SCR_OFF = MEM_KBYTES + MEM_VBYTES;
__device__ __forceinline__ void mem_unit(Frame& F, int unit, const float* mem_norm_w) {
    const int lane_ = fresh_lane(), tid_ = F.wave * 64 + lane_; (void)tid_;
    const int tb = unit & 15, bh = unit >> 4, b = bh >> 2, hh = bh & 3;
    const int tid = tid_, lane = lane_, wave = F.wave, c = lane & 31, h = lane >> 5;
    const bf16* PROJ = (const bf16*)(F.ws + WS_PROJ); const bf16* MKV = (const bf16*)(F.ws + WS_MKV); bf16* OMIX = (bf16*)(F.ws + WS_OMIX);
    const LAS unsigned char* Kl = F.lds; const LAS unsigned char* Vl = F.lds + MEM_KBYTES;
    LAS float* scr = (LAS float*)(F.lds + MEM_SCR_OFF) + wave * 32;
    const size_t row0 = (size_t)b * SEQ + tb * 256 + wave * 32;
    __syncthreads();
    for (int i = tid; i < 256 * 16; i += NTHREADS) { const int r = i >> 4, ch = i & 15;
        const v4u kv = *(const v4u*)(MKV + (size_t)(b * NMEM + r) * NKV + hh * 128 + 8 * ch);
        const v4u vv = *(const v4u*)(MKV + (size_t)(b * NMEM + r) * NKV + 512 + hh * 128 + 8 * ch);
        *(LAS v4u*)(F.lds + r * SBK_STRIDE + 16 * ch) = kv; *(LAS v4u*)(F.lds + MEM_KBYTES + r * SBV_STRIDE + 16 * ch) = vv; }
    bf16x8 qf[8];
#pragma unroll
    for (int ks = 0; ks < 8; ++ks) qf[ks] = *(const bf16x8*)(PROJ + (row0 + c) * PROJ_LD + 5632 + hh * 128 + 16 * ks + 8 * h);
    __syncthreads();
    float m = -INFINITY;
    for (int kt = 0; kt < 4; ++kt) {
        f32x16 p0, p1;
#pragma unroll
        for (int r = 0; r < 16; ++r) { p0[r] = 0.f; p1[r] = 0.f; }
#pragma unroll
        for (int ks = 0; ks < 8; ++ks) {
            const bf16x8 a0 = *(const LAS bf16x8*)(Kl + (64 * kt + c) * SBK_STRIDE + (16 * ks + 8 * h) * 2);
            const bf16x8 a1 = *(const LAS bf16x8*)(Kl + (64 * kt + 32 + c) * SBK_STRIDE + (16 * ks + 8 * h) * 2);
            p0 = MFMA32(a0, qf[ks], p0); p1 = MFMA32(a1, qf[ks], p1);
        }
#pragma unroll
        for (int r = 0; r < 16; ++r) m = fmaxf(m, fmaxf(p0[r], p1[r]));
    }
    m = fmaxf(m, __shfl_xor(m, 32));
    f32x16 o[4];
#pragma unroll
    for (int d = 0; d < 4; ++d)
#pragma unroll
        for (int r = 0; r < 16; ++r) o[d][r] = 0.f;
    float psum = 0.f;
    const LAS unsigned char* vb = Vl + (4 * h + ((lane & 15) >> 2)) * SBV_STRIDE + (((lane >> 4) & 1) * 16 + (lane & 3) * 4) * 2;
    for (int kt = 0; kt < 4; ++kt) {
        f32x16 p0, p1;
#pragma unroll
        for (int r = 0; r < 16; ++r) { p0[r] = -m; p1[r] = -m; }
#pragma unroll
        for (int ks = 0; ks < 8; ++ks) {
            const bf16x8 a0 = *(const LAS bf16x8*)(Kl + (64 * kt + c) * SBK_STRIDE + (16 * ks + 8 * h) * 2);
            const bf16x8 a1 = *(const LAS bf16x8*)(Kl + (64 * kt + 32 + c) * SBK_STRIDE + (16 * ks + 8 * h) * 2);
            p0 = MFMA32(a0, qf[ks], p0); p1 = MFMA32(a1, qf[ks], p1);
        }
#pragma unroll
        for (int r = 0; r < 16; ++r) { p0[r] = __expf(p0[r] * 0.08838834764831845f); p1[r] = __expf(p1[r] * 0.08838834764831845f); psum += p0[r] + p1[r]; }
        bf16x8 pa[4]; pa[0] = pack8<0>(p0); pa[1] = pack8<1>(p0); pa[2] = pack8<0>(p1); pa[3] = pack8<1>(p1);
#pragma unroll
        for (int dt = 0; dt < 4; ++dt)
#pragma unroll
            for (int kv = 0; kv < 4; ++kv) {
                const s16x4 lo = tr_read(vb + (64 * kt + 16 * kv) * SBV_STRIDE + dt * 64), hi = tr_read(vb + (64 * kt + 16 * kv + 8) * SBV_STRIDE + dt * 64);
                o[dt] = MFMA32(pa[kv], cat8(lo, hi), o[dt]);
            }
    }
    psum += __shfl_xor(psum, 32);
    if (h == 0) scr[c] = 1.f / psum;
    asm volatile("s_waitcnt lgkmcnt(0)" ::: "memory");
    float rinv[16];
#pragma unroll
    for (int r = 0; r < 16; ++r) { const float il = scr[crow(r, h)];
        o[0][r] *= il; o[1][r] *= il; o[2][r] *= il; o[3][r] *= il;
        float ss = o[0][r] * o[0][r] + o[1][r] * o[1][r] + o[2][r] * o[2][r] + o[3][r] * o[3][r];
        ss += __shfl_xor(ss, 1); ss += __shfl_xor(ss, 2); ss += __shfl_xor(ss, 4); ss += __shfl_xor(ss, 8); ss += __shfl_xor(ss, 16);
        rinv[r] = rsqrtf(ss * (1.f / HD) + RMS_EPS); }
#pragma unroll
    for (int dt = 0; dt < 4; ++dt) { const float nw = mem_norm_w[hh * 128 + 32 * dt + c];
#pragma unroll
        for (int r = 0; r < 16; ++r) OMIX[(row0 + crow(r, h)) * D + 1536 + hh * 128 + 32 * dt + c] = (bf16)f2bf(o[dt][r] * rinv[r] * nw); }
}

struct Epi2 {
    static constexpr bool PERM = true, AFTER_DRAIN = false;
    const bf16* H; bf16* Y;
    __device__ __forceinline__ void operator()(const pg8::f32x4 (&acc)[2][2][4][2], const pg8::Unit& u, int wr, int wc, int fr, int fq) const {
        const int row0 = u.pm * 256 + wr * 64 + fr, col0 = u.pn * 256 + wc * 32 + 8 * fq;
#pragma unroll
        for (int ai = 0; ai < 2; ++ai)
#pragma unroll
            for (int m = 0; m < 4; ++m) { const size_t off = (size_t)(row0 + ai * 128 + m * 16) * D + col0;
#pragma unroll
                for (int bj = 0; bj < 2; ++bj) { const v4u h4 = *(const v4u*)(H + off + bj * 128);
                    const pg8::f32x4 v0 = acc[ai][bj][m][0], v1 = acc[ai][bj][m][1];
                    v4u w; w.x = pk2(v0[0] + ALPHA * bflo(h4.x), v0[1] + ALPHA * bfhi(h4.x)); w.y = pk2(v0[2] + ALPHA * bflo(h4.y), v0[3] + ALPHA * bfhi(h4.y));
                    w.z = pk2(v1[0] + ALPHA * bflo(h4.z), v1[1] + ALPHA * bfhi(h4.z)); w.w = pk2(v1[2] + ALPHA * bflo(h4.w), v1[3] + ALPHA * bfhi(h4.w));
                    *(v4u*)(Y + off + bj * 128) = w; } }
    }
};
struct Epi3 {
    static constexpr bool PERM = true, AFTER_DRAIN = false;
    bf16* O;
    __device__ __forceinline__ void operator()(const pg8::f32x4 (&acc)[2][2][4][2], const pg8::Unit& u, int wr, int wc, int fr, int fq) const {
        const int row0 = u.pm * 256 + wr * 64 + fr, col0 = u.pn * 256 + wc * 32 + 8 * fq;
#pragma unroll
        for (int ai = 0; ai < 2; ++ai)
#pragma unroll
            for (int m = 0; m < 4; ++m) { bf16* rowp = O + (size_t)(row0 + ai * 128 + m * 16) * D + col0;
#pragma unroll
                for (int bj = 0; bj < 2; ++bj) { const pg8::f32x4 v0 = acc[ai][bj][m][0], v1 = acc[ai][bj][m][1];
                    pg8::u32x4 w; w.x = pg8::cvt_pk_bf16(v0[0], v0[1]); w.y = pg8::cvt_pk_bf16(v0[2], v0[3]); w.z = pg8::cvt_pk_bf16(v1[0], v1[1]); w.w = pg8::cvt_pk_bf16(v1[2], v1[3]);
                    *(pg8::u32x4*)(rowp + bj * 128) = w; } }
    }
};

__device__ __forceinline__ void p5_ln1_tables(Frame& F, const float* l1w, const float* l1b, const float* pu, const float* pv) {
    const int lane_ = fresh_lane(), tid_ = F.wave * 64 + lane_; (void)tid_;
    const int gw = F.vcu * NWAVES + F.wave, NGW = F.G * NWAVES;
    const bf16* Y1 = (const bf16*)(F.ws + WS_Y1); bf16* XN2 = (bf16*)(F.ws + WS_XN);
    unsigned char* XQ = F.ws + WS_XQ; float* XST = (float*)(F.ws + WS_XSTEP);
    for (int m = gw; m < M; m += 2 * NGW) ln_rows2_bf16in(Y1 + (size_t)m * D, Y1 + (size_t)(m + NGW) * D, l1w, l1b, XN2 + (size_t)m * D, XN2 + (size_t)(m + NGW) * D,
                                                          XQ + (size_t)m * D, XQ + (size_t)(m + NGW) * D, XST + (size_t)m * 8, XST + (size_t)(m + NGW) * 8, lane_);
}

__device__ __forceinline__ void peer_tables_convert(Frame& F, const float* pu, const float* pv, const int gwt, const int ngwt, const int slot) {
    const int lane_ = fresh_lane(); const int gw = gwt, NGW = ngwt;
    float smx[8];
#pragma unroll
    for (int j = 0; j < 8; ++j) smx[j] = 0.f;
    for (int r2 = gw; r2 < 2 * PE_NEXP; r2 += NGW) {
        const int tsel = r2 >= PE_NEXP, e = r2 - tsel * PE_NEXP;
        const f32x4* src = (const f32x4*)((tsel ? pv : pu) + (size_t)e * D) + lane_;
        unsigned char* trow = F.ws + (tsel ? WS_VT : WS_UT) + (size_t)e * UROW;
        f32x4 v[8];
#pragma unroll
        for (int j = 0; j < 8; ++j) v[j] = src[64 * j];
        const int ob = tsel ? 8 : 0;
#pragma unroll
        for (int j = 0; j < 8; ++j) {
            float am = fmaxf(fmaxf(fabsf(v[j].x), fabsf(v[j].y)), fmaxf(fabsf(v[j].z), fabsf(v[j].w)));
            am = fmaxf(am, __shfl_xor(am, 1)); am = fmaxf(am, __shfl_xor(am, 2)); am = fmaxf(am, __shfl_xor(am, 4));
            const float inv = am > 0.f ? 7.f / am : 0.f;
            const unsigned mine = (unsigned)(((int)rintf(v[j].x * inv) + ob) & 15) | ((unsigned)(((int)rintf(v[j].y * inv) + ob) & 15) << 8)
                                | ((unsigned)(((int)rintf(v[j].z * inv) + ob) & 15) << 16) | ((unsigned)(((int)rintf(v[j].w * inv) + ob) & 15) << 24);
            const unsigned other = (unsigned)__shfl_xor((int)mine, 1);
            if (tsel) {
                if ((lane_ & 1) == 0) *(unsigned*)(trow + 4 * ((lane_ >> 1) + 32 * j)) = mine | (other << 4);
                if ((lane_ & 7) == 0) *(bf16*)(trow + 1024 + 2 * ((lane_ >> 3) + 8 * j)) = (bf16)f2bf(am * (1.f / 7.f));
            } else {
                if ((lane_ & 1) == 0) *(unsigned*)(F.ws + WS_UT + (size_t)j * UT_SLICE + (size_t)e * 128 + 4 * (lane_ >> 1)) = mine | (other << 4);
                const bf16 stp = (bf16)f2bf(am * (1.f / 7.f));
                if ((lane_ & 7) == 0) *(bf16*)(F.ws + WS_UT + US_OFF + (size_t)j * US_SLICE + (size_t)e * 16 + 2 * (lane_ >> 3)) = stp;
                smx[j] = fmaxf(smx[j], bf2f(stp));
            }
        }
    }
    float* SMW = (float*)(F.ws + WS_SMW) + (size_t)slot * 8;
#pragma unroll
    for (int j = 0; j < 8; ++j) { const float m = wave_max(smx[j]); if (lane_ == 0) SMW[j] = m; }
}


__device__ __forceinline__ float partner32(float y, int h) { const auto rr = __builtin_amdgcn_permlane32_swap(__float_as_uint(y), __float_as_uint(y), false, false); return __uint_as_float(h ? rr[0] : rr[1]); }
__device__ __forceinline__ float max3f(float a, float b, float c) { return fmaxf(fmaxf(a, b), c); }
template <int N> __device__ __forceinline__ float maxN(const float (&v)[N]) {
    float m[(N + 2) / 3];
#pragma unroll
    for (int i = 0; i < (N + 2) / 3; ++i) { const float a = v[3 * i], b = (3 * i + 1 < N) ? v[3 * i + 1] : a, c = (3 * i + 2 < N) ? v[3 * i + 2] : a; m[i] = max3f(a, b, c); }
    if constexpr ((N + 2) / 3 == 1) return m[0]; else return maxN<(N + 2) / 3>(m);
}
template <int N> __device__ __forceinline__ void top16_regs(float (&v)[N], float (&top)[16]) {
#pragma unroll
    for (int r = 0; r < 16; ++r) { const float m = maxN<N>(v); top[r] = m;
#pragma unroll
        for (int i = 0; i < N; ++i) v[i] = (v[i] == m) ? -INFINITY : v[i]; }
}
__device__ __forceinline__ void merge_partner(const float (&own)[16], float (&t)[16], int h) {
#pragma unroll
    for (int i = 0; i < 16; ++i) t[i] = fmaxf(own[i], partner32(own[15 - i], h));
}
__device__ __forceinline__ void sort16_desc(float (&t)[16]) {
#pragma unroll
    for (int k = 2; k <= 16; k <<= 1)
#pragma unroll
        for (int j = k >> 1; j > 0; j >>= 1)
#pragma unroll
            for (int i = 0; i < 16; ++i) { const int l = i ^ j; if (l > i) { const float a = t[i], b = t[l]; const float mx = fmaxf(a, b), mn = fminf(a, b); if ((i & k) == 0) { t[i] = mx; t[l] = mn; } else { t[i] = mn; t[l] = mx; } } }
}
__device__ __forceinline__ void merge16_desc(float (&t)[16]) {
#pragma unroll
    for (int j = 8; j > 0; j >>= 1)
#pragma unroll
        for (int i = 0; i < 16; ++i) if ((i & j) == 0) { const float a = t[i], b = t[i + j]; t[i] = fmaxf(a, b); t[i + j] = fminf(a, b); }
}
__device__ __forceinline__ void peer_half_top16(const LAS unsigned char* Kh, const bf16* qh, int c, int h, float (&out)[16]) {
    bf16x8 qf[8];
#pragma unroll
    for (int ks = 0; ks < 8; ++ks) qf[ks] = *(const bf16x8*)(qh + 16 * ks + 8 * h);
    float sv[64];
#pragma unroll
    for (int rt = 0; rt < 4; ++rt) {
        f32x16 acc;
#pragma unroll
        for (int r = 0; r < 16; ++r) acc[r] = 0.f;
#pragma unroll
        for (int ks = 0; ks < 8; ++ks) acc = MFMA32(*(const LAS bf16x8*)(Kh + (32 * rt + c) * MK_STRIDE + (16 * ks + 8 * h) * 2), qf[ks], acc);
#pragma unroll
        for (int r = 0; r < 16; ++r) sv[rt * 16 + r] = __uint_as_float((__float_as_uint(acc[r]) & ~0x7Fu) | (unsigned)(32 * rt + (r & 3) + 8 * (r >> 2)) | ((unsigned)h << 2));
    }
    float g0[16], g1[16], g2[16], g3[16];
#pragma unroll
    for (int i = 0; i < 16; ++i) { g0[i] = sv[i]; g1[i] = sv[16 + i]; g2[i] = sv[32 + i]; g3[i] = sv[48 + i]; }
    sort16_desc(g0); sort16_desc(g1); sort16_desc(g2); sort16_desc(g3);
    float m01[16], m23[16], top[16];
#pragma unroll
    for (int i = 0; i < 16; ++i) { m01[i] = fmaxf(g0[i], g1[15 - i]); m23[i] = fmaxf(g2[i], g3[15 - i]); }
    merge16_desc(m01); merge16_desc(m23);
#pragma unroll
    for (int i = 0; i < 16; ++i) top[i] = fmaxf(m01[i], m23[15 - i]);
    merge16_desc(top);
    merge_partner(top, out, h);
    merge16_desc(out);
}
__device__ __forceinline__ void p7_peer_scores(Frame& F, const float* keys1, const float* keys2) {
    const int lane = fresh_lane(), tid = F.wave * 64 + lane, c = lane & 31, h = lane >> 5;
    LAS unsigned char* K1 = F.lds; LAS unsigned char* K2 = F.lds + 128 * MK_STRIDE;
    __syncthreads();
    for (int i = tid; i < 2 * 128 * 16; i += NTHREADS) { const int which = i >> 11, r = (i >> 4) & 127, ch = i & 15;
        const float* src = (which ? keys2 : keys1) + r * 128 + 8 * ch; const f32x4 a = *(const f32x4*)src, b = *(const f32x4*)(src + 4);
        v4u o; o.x = pk2(a.x, a.y); o.y = pk2(a.z, a.w); o.z = pk2(b.x, b.y); o.w = pk2(b.z, b.w);
        *(LAS v4u*)((which ? K2 : K1) + r * MK_STRIDE + 16 * ch) = o; }
    __syncthreads();
    const bf16* Q = (const bf16*)(F.ws + WS_Q); int* IDX = (int*)(F.ws + WS_IDX); float* GATE = (float*)(F.ws + WS_GATE);
    const int gw = F.vcu * NWAVES + F.wave, NGW = F.G * NWAVES;
    for (int item = gw; item < (M / 32) * PE_HEADS; item += NGW) {
        const int tt = item >> 3, hd = item & 7; const size_t token = (size_t)tt * 32 + c;
        const bf16* qrow = Q + token * D + hd * 256;
        float v1[16], v2[16];
        peer_half_top16(K1, qrow, c, h, v1);
        peer_half_top16(K2, qrow + 128, c, h, v2);
        const int hq = fresh_lane() >> 5;
        float cs[25]; int cp[25];
        { const float x1 = hq ? v1[0] : v1[0], x2 = hq ? v2[1] : v2[0]; cs[0] = __uint_as_float((__float_as_uint(x1 + x2) & ~0x3Fu) | (unsigned)(0) | ((unsigned)hq << 5)); cp[0] = (int)(((__float_as_uint(x1) & 0x7Fu) << 7) | (__float_as_uint(x2) & 0x7Fu)); }
        { const float x1 = hq ? v1[0] : v1[0], x2 = hq ? v2[3] : v2[2]; cs[1] = __uint_as_float((__float_as_uint(x1 + x2) & ~0x3Fu) | (unsigned)(1) | ((unsigned)hq << 5)); cp[1] = (int)(((__float_as_uint(x1) & 0x7Fu) << 7) | (__float_as_uint(x2) & 0x7Fu)); }
        { const float x1 = hq ? v1[0] : v1[0], x2 = hq ? v2[5] : v2[4]; cs[2] = __uint_as_float((__float_as_uint(x1 + x2) & ~0x3Fu) | (unsigned)(2) | ((unsigned)hq << 5)); cp[2] = (int)(((__float_as_uint(x1) & 0x7Fu) << 7) | (__float_as_uint(x2) & 0x7Fu)); }
        { const float x1 = hq ? v1[0] : v1[0], x2 = hq ? v2[7] : v2[6]; cs[3] = __uint_as_float((__float_as_uint(x1 + x2) & ~0x3Fu) | (unsigned)(3) | ((unsigned)hq << 5)); cp[3] = (int)(((__float_as_uint(x1) & 0x7Fu) << 7) | (__float_as_uint(x2) & 0x7Fu)); }
        { const float x1 = hq ? v1[0] : v1[0], x2 = hq ? v2[9] : v2[8]; cs[4] = __uint_as_float((__float_as_uint(x1 + x2) & ~0x3Fu) | (unsigned)(4) | ((unsigned)hq << 5)); cp[4] = (int)(((__float_as_uint(x1) & 0x7Fu) << 7) | (__float_as_uint(x2) & 0x7Fu)); }
        { const float x1 = hq ? v1[0] : v1[0], x2 = hq ? v2[11] : v2[10]; cs[5] = __uint_as_float((__float_as_uint(x1 + x2) & ~0x3Fu) | (unsigned)(5) | ((unsigned)hq << 5)); cp[5] = (int)(((__float_as_uint(x1) & 0x7Fu) << 7) | (__float_as_uint(x2) & 0x7Fu)); }
        { const float x1 = hq ? v1[0] : v1[0], x2 = hq ? v2[13] : v2[12]; cs[6] = __uint_as_float((__float_as_uint(x1 + x2) & ~0x3Fu) | (unsigned)(6) | ((unsigned)hq << 5)); cp[6] = (int)(((__float_as_uint(x1) & 0x7Fu) << 7) | (__float_as_uint(x2) & 0x7Fu)); }
        { const float x1 = hq ? v1[0] : v1[0], x2 = hq ? v2[15] : v2[14]; cs[7] = __uint_as_float((__float_as_uint(x1 + x2) & ~0x3Fu) | (unsigned)(7) | ((unsigned)hq << 5)); cp[7] = (int)(((__float_as_uint(x1) & 0x7Fu) << 7) | (__float_as_uint(x2) & 0x7Fu)); }
        { const float x1 = hq ? v1[1] : v1[1], x2 = hq ? v2[1] : v2[0]; cs[8] = __uint_as_float((__float_as_uint(x1 + x2) & ~0x3Fu) | (unsigned)(8) | ((unsigned)hq << 5)); cp[8] = (int)(((__float_as_uint(x1) & 0x7Fu) << 7) | (__float_as_uint(x2) & 0x7Fu)); }
        { const float x1 = hq ? v1[1] : v1[1], x2 = hq ? v2[3] : v2[2]; cs[9] = __uint_as_float((__float_as_uint(x1 + x2) & ~0x3Fu) | (unsigned)(9) | ((unsigned)hq << 5)); cp[9] = (int)(((__float_as_uint(x1) & 0x7Fu) << 7) | (__float_as_uint(x2) & 0x7Fu)); }
        { const float x1 = hq ? v1[1] : v1[1], x2 = hq ? v2[5] : v2[4]; cs[10] = __uint_as_float((__float_as_uint(x1 + x2) & ~0x3Fu) | (unsigned)(10) | ((unsigned)hq << 5)); cp[10] = (int)(((__float_as_uint(x1) & 0x7Fu) << 7) | (__float_as_uint(x2) & 0x7Fu)); }
        { const float x1 = hq ? v1[1] : v1[1], x2 = hq ? v2[7] : v2[6]; cs[11] = __uint_as_float((__float_as_uint(x1 + x2) & ~0x3Fu) | (unsigned)(11) | ((unsigned)hq << 5)); cp[11] = (int)(((__float_as_uint(x1) & 0x7Fu) << 7) | (__float_as_uint(x2) & 0x7Fu)); }
        { const float x1 = hq ? v1[2] : v1[2], x2 = hq ? v2[1] : v2[0]; cs[12] = __uint_as_float((__float_as_uint(x1 + x2) & ~0x3Fu) | (unsigned)(12) | ((unsigned)hq << 5)); cp[12] = (int)(((__float_as_uint(x1) & 0x7Fu) << 7) | (__float_as_uint(x2) & 0x7Fu)); }
        { const float x1 = hq ? v1[2] : v1[2], x2 = hq ? v2[3] : v2[2]; cs[13] = __uint_as_float((__float_as_uint(x1 + x2) & ~0x3Fu) | (unsigned)(13) | ((unsigned)hq << 5)); cp[13] = (int)(((__float_as_uint(x1) & 0x7Fu) << 7) | (__float_as_uint(x2) & 0x7Fu)); }
        { const float x1 = hq ? v1[3] : v1[2], x2 = hq ? v2[0] : v2[4]; cs[14] = __uint_as_float((__float_as_uint(x1 + x2) & ~0x3Fu) | (unsigned)(14) | ((unsigned)hq << 5)); cp[14] = (int)(((__float_as_uint(x1) & 0x7Fu) << 7) | (__float_as_uint(x2) & 0x7Fu)); }
        { const float x1 = hq ? v1[3] : v1[3], x2 = hq ? v2[2] : v2[1]; cs[15] = __uint_as_float((__float_as_uint(x1 + x2) & ~0x3Fu) | (unsigned)(15) | ((unsigned)hq << 5)); cp[15] = (int)(((__float_as_uint(x1) & 0x7Fu) << 7) | (__float_as_uint(x2) & 0x7Fu)); }
        { const float x1 = hq ? v1[4] : v1[3], x2 = hq ? v2[0] : v2[3]; cs[16] = __uint_as_float((__float_as_uint(x1 + x2) & ~0x3Fu) | (unsigned)(16) | ((unsigned)hq << 5)); cp[16] = (int)(((__float_as_uint(x1) & 0x7Fu) << 7) | (__float_as_uint(x2) & 0x7Fu)); }
        { const float x1 = hq ? v1[4] : v1[4], x2 = hq ? v2[2] : v2[1]; cs[17] = __uint_as_float((__float_as_uint(x1 + x2) & ~0x3Fu) | (unsigned)(17) | ((unsigned)hq << 5)); cp[17] = (int)(((__float_as_uint(x1) & 0x7Fu) << 7) | (__float_as_uint(x2) & 0x7Fu)); }
        { const float x1 = hq ? v1[5] : v1[5], x2 = hq ? v2[1] : v2[0]; cs[18] = __uint_as_float((__float_as_uint(x1 + x2) & ~0x3Fu) | (unsigned)(18) | ((unsigned)hq << 5)); cp[18] = (int)(((__float_as_uint(x1) & 0x7Fu) << 7) | (__float_as_uint(x2) & 0x7Fu)); }
        { const float x1 = hq ? v1[6] : v1[6], x2 = hq ? v2[1] : v2[0]; cs[19] = __uint_as_float((__float_as_uint(x1 + x2) & ~0x3Fu) | (unsigned)(19) | ((unsigned)hq << 5)); cp[19] = (int)(((__float_as_uint(x1) & 0x7Fu) << 7) | (__float_as_uint(x2) & 0x7Fu)); }
        { const float x1 = hq ? v1[7] : v1[7], x2 = hq ? v2[1] : v2[0]; cs[20] = __uint_as_float((__float_as_uint(x1 + x2) & ~0x3Fu) | (unsigned)(20) | ((unsigned)hq << 5)); cp[20] = (int)(((__float_as_uint(x1) & 0x7Fu) << 7) | (__float_as_uint(x2) & 0x7Fu)); }
        { const float x1 = hq ? v1[9] : v1[8], x2 = hq ? v2[0] : v2[0]; cs[21] = __uint_as_float((__float_as_uint(x1 + x2) & ~0x3Fu) | (unsigned)(21) | ((unsigned)hq << 5)); cp[21] = (int)(((__float_as_uint(x1) & 0x7Fu) << 7) | (__float_as_uint(x2) & 0x7Fu)); }
        { const float x1 = hq ? v1[11] : v1[10], x2 = hq ? v2[0] : v2[0]; cs[22] = __uint_as_float((__float_as_uint(x1 + x2) & ~0x3Fu) | (unsigned)(22) | ((unsigned)hq << 5)); cp[22] = (int)(((__float_as_uint(x1) & 0x7Fu) << 7) | (__float_as_uint(x2) & 0x7Fu)); }
        { const float x1 = hq ? v1[13] : v1[12], x2 = hq ? v2[0] : v2[0]; cs[23] = __uint_as_float((__float_as_uint(x1 + x2) & ~0x3Fu) | (unsigned)(23) | ((unsigned)hq << 5)); cp[23] = (int)(((__float_as_uint(x1) & 0x7Fu) << 7) | (__float_as_uint(x2) & 0x7Fu)); }
        { const float x1 = hq ? v1[15] : v1[14], x2 = hq ? v2[0] : v2[0]; cs[24] = __uint_as_float((__float_as_uint(x1 + x2) & ~0x3Fu) | (unsigned)(24) | ((unsigned)hq << 5)); cp[24] = (int)(((__float_as_uint(x1) & 0x7Fu) << 7) | (__float_as_uint(x2) & 0x7Fu)); }
        float ctop[16], ft[16]; int ctp[16], fp[16];
#pragma unroll
        for (int r = 0; r < 16; ++r) { const float m = maxN<25>(cs); ctop[r] = m; int p = 0;
#pragma unroll
            for (int i = 0; i < 25; ++i) { const bool eq = (cs[i] == m); p = eq ? cp[i] : p; cs[i] = eq ? -INFINITY : cs[i]; }
            ctp[r] = p; }
#pragma unroll
        for (int i = 0; i < 16; ++i) { const float py = partner32(ctop[15 - i], h); const int pp = (int)__float_as_uint(partner32(__uint_as_float((unsigned)ctp[15 - i]), h));
            ft[i] = fmaxf(ctop[i], py); fp[i] = (ctop[i] >= py) ? ctp[i] : pp; }
        const float mx = maxN<16>(ft); float e[16], sum = 0.f;
#pragma unroll
        for (int i = 0; i < 16; ++i) { e[i] = __expf(ft[i] - mx); sum += e[i]; }
        const float inv = 1.f / sum;
        int idx8[8]; float g8[8];
#pragma unroll
        for (int i = 0; i < 8; ++i) { idx8[i] = fp[i]; g8[i] = e[i] * inv; }
        int* ip = IDX + token * PE_SEL + hd * 16 + 8 * h; float* gp = GATE + token * PE_SEL + hd * 16 + 8 * h;
        *(v4u*)ip = (v4u){(unsigned)idx8[0], (unsigned)idx8[1], (unsigned)idx8[2], (unsigned)idx8[3]}; *(v4u*)(ip + 4) = (v4u){(unsigned)idx8[4], (unsigned)idx8[5], (unsigned)idx8[6], (unsigned)idx8[7]};
        *(f32x4*)gp = (f32x4){g8[0], g8[1], g8[2], g8[3]}; *(f32x4*)(gp + 4) = (f32x4){g8[4], g8[5], g8[6], g8[7]};
    }
}

__device__ __forceinline__ float gelu_exact(float x) { return 0.5f * x * (1.f + erff(x * 0.7071067811865476f)); }
__device__ __forceinline__ float ub0(unsigned w) { float f; asm("v_cvt_f32_ubyte0_e32 %0, %1" : "=v"(f) : "v"(w)); return f; }
__device__ __forceinline__ float ub1(unsigned w) { float f; asm("v_cvt_f32_ubyte1_e32 %0, %1" : "=v"(f) : "v"(w)); return f; }
__device__ __forceinline__ float ub2(unsigned w) { float f; asm("v_cvt_f32_ubyte2_e32 %0, %1" : "=v"(f) : "v"(w)); return f; }
__device__ __forceinline__ float ub3(unsigned w) { float f; asm("v_cvt_f32_ubyte3_e32 %0, %1" : "=v"(f) : "v"(w)); return f; }
typedef int v4i_t __attribute__((ext_vector_type(4)));
#define DPP_ADD(v, ctrl) ((v) + __uint_as_float((unsigned)__builtin_amdgcn_update_dpp(0, (int)__float_as_uint(v), (ctrl), 0xF, 0xF, true)))
__device__ __forceinline__ void p8a_peer_u(Frame& F) {
    const int lane = fresh_lane(); const int c = lane & 7, jg = lane >> 3;
    const int x = (int)blockIdx.x & 7, nr = (F.G - x + 7) >> 3, rank = (int)blockIdx.x >> 3;
    const int w0 = rank * NWAVES + F.wave, nw = nr * NWAVES;
    const unsigned char* UTx = F.ws + WS_UT + (size_t)x * UT_SLICE + 16 * c; const unsigned char* USx = F.ws + WS_UT + US_OFF + (size_t)x * US_SLICE + 2 * c;
    const int* IDX = (const int*)(F.ws + WS_IDX) + 16 * jg; const unsigned char* XQ = F.ws + WS_XQ + 128 * x + 16 * c; const float* XST = (const float*)(F.ws + WS_XSTEP) + x;
    float* PART = (float*)(F.ws + WS_PART) + (size_t)x * M * PE_SEL + 16 * jg;
    float smax;
    {
        const int tid_ = F.wave * 64 + lane; const int nslots = (F.G - BATCH * GH) * NWAVES;
        const float* SMW = (const float*)(F.ws + WS_SMW) + x; float m = 0.f;
        for (int i = tid_; i < nslots; i += NTHREADS) m = fmaxf(m, SMW[(size_t)i * 8]);
        m = wave_max(m);
        __syncthreads();
        if (lane == 0) *(LAS float*)(F.lds + 4 * F.wave) = m;
        __syncthreads();
        smax = 0.f;
#pragma unroll
        for (int w = 0; w < NWAVES; ++w) smax = fmaxf(smax, *(const LAS float*)(F.lds + 4 * w));
        const float sinv = smax > 0.f ? 255.f / smax : 0.f;
        __syncthreads();
#pragma unroll 8
        for (int r = tid_; r < PE_NEXP; r += NTHREADS) { const v4u sv = *(const v4u*)(USx - 2 * c + (size_t)r * 16); v2u o;
            o.x = (unsigned)fminf(rintf(bflo(sv.x) * sinv), 255.f) | ((unsigned)fminf(rintf(bfhi(sv.x) * sinv), 255.f) << 8) | ((unsigned)fminf(rintf(bflo(sv.y) * sinv), 255.f) << 16) | ((unsigned)fminf(rintf(bfhi(sv.y) * sinv), 255.f) << 24);
            o.y = (unsigned)fminf(rintf(bflo(sv.z) * sinv), 255.f) | ((unsigned)fminf(rintf(bfhi(sv.z) * sinv), 255.f) << 8) | ((unsigned)fminf(rintf(bflo(sv.w) * sinv), 255.f) << 16) | ((unsigned)fminf(rintf(bfhi(sv.w) * sinv), 255.f) << 24);
            *(LAS v2u*)(F.lds + 8 * r) = o; }
        __syncthreads();
    }
    const float sunit = smax * (1.f / 255.f);
#define P8A_LOADTOK(tt, E, XA, XB, XS) do { const int t_ = (tt) < M ? (tt) : M - 1; _Pragma("unroll") for (int q = 0; q < 4; ++q) E[q] = *(const v4i_t*)(IDX + (size_t)t_ * PE_SEL + 4 * q); \
        XA = *(const v4u*)(XQ + (size_t)t_ * D); XB = *(const v4u*)(XQ + (size_t)t_ * D + 1024); XS = XST[(size_t)t_ * 8]; } while (0)
#define P8A_ROW(slot, e_) do { const int e__ = (e_); a[slot] = *(const v4u*)(UTx + (size_t)e__ * 128); } while (0)
    v4i_t ec[4], en[4], e2[4]; v4u xac, xbc, xan, xbn, xa2, xb2; float xsc, xsn, xs2;
    P8A_LOADTOK(w0, ec, xac, xbc, xsc); P8A_LOADTOK(w0 + nw, en, xan, xbn, xsn);
    v4u a[16];
#ifndef P8A_DIST
#define P8A_DIST 8
#endif
#pragma unroll
    for (int i = 0; i < P8A_DIST; ++i) P8A_ROW(i, ec[i >> 2][i & 3]);
    for (int t = w0; t < M; t += nw) {
        P8A_LOADTOK(t + 2 * nw, e2, xa2, xb2, xs2);
        asm volatile("" ::: "memory");
        unsigned char gs[16];
#pragma unroll
        for (int i = 0; i < 16; ++i) gs[i] = *(const LAS unsigned char*)(F.lds + 8 * ec[i >> 2][i & 3] + c);
        const float xsu = xsc * sunit;
        float sf[16];
#pragma unroll
        for (int i = 0; i < 16; ++i) {
            if (i + P8A_DIST < 16) P8A_ROW(i + P8A_DIST, ec[(i + P8A_DIST) >> 2][(i + P8A_DIST) & 3]); else P8A_ROW(i + P8A_DIST - 16, en[(i + P8A_DIST - 16) >> 2][(i + P8A_DIST - 16) & 3]);
            asm volatile("" ::: "memory");
            int sh_ = 0, sl_ = 0;
#pragma unroll
            for (int d4 = 0; d4 < 4; ++d4) { sh_ = __builtin_amdgcn_sdot8((int)a[i][d4], (int)xac[d4], sh_, false); sl_ = __builtin_amdgcn_sdot8((int)a[i][d4], (int)xbc[d4], sl_, false); }
            const int sdt = (sh_ << 4) + sl_;
            float v = (float)sdt * (float)gs[i];
            v = DPP_ADD(v, 0xB1); v = DPP_ADD(v, 0x4E); v = DPP_ADD(v, 0x141);
            sf[i] = v * xsu;
        }
        if (c == 0) {
#pragma unroll
            for (int q = 0; q < 4; ++q) { f32x4 o; o.x = sf[4 * q]; o.y = sf[4 * q + 1]; o.z = sf[4 * q + 2]; o.w = sf[4 * q + 3]; *(f32x4*)(PART + (size_t)t * PE_SEL + 4 * q) = o; }
        }
#pragma unroll
        for (int q = 0; q < 4; ++q) { ec[q] = en[q]; en[q] = e2[q]; }
        xac = xan; xbc = xbn; xsc = xsn; xan = xa2; xbn = xb2; xsn = xs2;
    }
#undef P8A_LOADTOK
#undef P8A_ROW
}
__device__ __forceinline__ void p8_peer_experts(Frame& F, const float* l2w, const float* l2b) {
    const int lane = fresh_lane(); const int gw = F.vcu * NWAVES + F.wave, NGW = F.G * NWAVES;
    const bf16* XN2 = (const bf16*)(F.ws + WS_XN); const unsigned char* U8 = F.ws + WS_UT; const unsigned char* V8 = F.ws + WS_VT;
    const float* USTEP = (const float*)(F.ws + WS_USTEP); const float* VSTEP = (const float*)(F.ws + WS_VSTEP);
    const int* IDX = (const int*)(F.ws + WS_IDX); const float* GATE = (const float*)(F.ws + WS_GATE); const float* PART = (const float*)(F.ws + WS_PART);
    for (int row = gw; row < M; row += NGW) {
        float x[32], acc[32];
#pragma unroll
        for (int q = 0; q < 4; ++q) { const v4u xv = *(const v4u*)(XN2 + (size_t)row * D + 32 * lane + 8 * q);
            float* xp = x + 8 * q; xp[0] = bflo(xv.x); xp[1] = bfhi(xv.x); xp[2] = bflo(xv.y); xp[3] = bfhi(xv.y); xp[4] = bflo(xv.z); xp[5] = bfhi(xv.z); xp[6] = bflo(xv.w); xp[7] = bfhi(xv.w); }
#pragma unroll
        for (int i = 0; i < 32; ++i) acc[i] = 0.f;
        float wtot = 0.f;
        const int my_e0 = IDX[(size_t)row * PE_SEL + lane], my_e1 = IDX[(size_t)row * PE_SEL + 64 + lane];
        float my_w0, my_w1;
        { const float g0 = GATE[(size_t)row * PE_SEL + lane], g1 = GATE[(size_t)row * PE_SEL + 64 + lane]; float d0 = 0.f, d1 = 0.f;
#pragma unroll
          for (int xs_ = 0; xs_ < 8; ++xs_) { d0 += PART[(size_t)xs_ * M * PE_SEL + (size_t)row * PE_SEL + lane]; d1 += PART[(size_t)xs_ * M * PE_SEL + (size_t)row * PE_SEL + 64 + lane]; }
          my_w0 = g0 * gelu_exact(d0); my_w1 = g1 * gelu_exact(d1); }
        v4u a[8]; bf16 gs[8];
#define P8V_ROW(slot, e_) do { const unsigned char* vp__ = V8 + (size_t)(e_) * UROW; a[slot] = *(const v4u*)(vp__ + 16 * lane); gs[slot] = *(const bf16*)(vp__ + 1024 + 2 * lane); } while (0)
#pragma unroll
        for (int i = 0; i < 4; ++i) P8V_ROW(i, __builtin_amdgcn_readlane(my_e0, i));
        for (int q = 0; q < 16; ++q) {
            const int my_e = q < 8 ? my_e0 : my_e1; const float my_w = q < 8 ? my_w0 : my_w1;
            const int my_en = q < 7 ? my_e0 : my_e1;
#pragma unroll
            for (int i = 0; i < 8; ++i) {
                { const int kp = 8 * q + i + 4; const int kc = kp < 128 ? kp : 127;
                  const int ep = (i < 4) ? __builtin_amdgcn_readlane(my_e, kc & 63) : __builtin_amdgcn_readlane(my_en, kc & 63);
                  P8V_ROW((i + 4) & 7, ep); }
                asm volatile("" ::: "memory");
                const float w0 = __uint_as_float((unsigned)__builtin_amdgcn_readlane((int)__float_as_uint(my_w), (8 * q + i) & 63));
                const float w = w0 * bf2f(gs[i]);
                wtot += w; const float w16 = w * 0.0625f;
#pragma unroll
                for (int d4 = 0; d4 < 4; ++d4) { const unsigned lo = a[i][d4] & 0x0F0F0F0Fu, by = a[i][d4];
                    acc[8 * d4] += w * ub0(lo); acc[8 * d4 + 1] += w * ub1(lo); acc[8 * d4 + 2] += w * ub2(lo); acc[8 * d4 + 3] += w * ub3(lo);
                    acc[8 * d4 + 4] += w16 * ub0(by); acc[8 * d4 + 5] += w16 * ub1(by); acc[8 * d4 + 6] += w16 * ub2(by); acc[8 * d4 + 7] += w16 * ub3(by); }
            }
        }
#undef P8V_ROW
        float s_ = 0.f;
#pragma unroll
        for (int d4 = 0; d4 < 4; ++d4)
#pragma unroll
            for (int b = 0; b < 4; ++b) acc[8 * d4 + 4 + b] -= 0.0625f * acc[8 * d4 + b];
#pragma unroll
        for (int i = 0; i < 32; ++i) { acc[i] = acc[i] - 8.f * wtot + ALPHA * x[i]; s_ += acc[i]; }
        const float mean = wave_sum(s_) * (1.f / D); float s2 = 0.f;
#pragma unroll
        for (int i = 0; i < 32; ++i) { acc[i] -= mean; s2 += acc[i] * acc[i]; }
        const float rstd = 1.f / sqrtf(wave_sum(s2) * (1.f / D) + LN_EPS);
#pragma unroll
        for (int q = 0; q < 8; ++q) {
            const int col = 32 * lane + 4 * q;
            const f32x4 w4 = *(const f32x4*)(l2w + col), b4 = *(const f32x4*)(l2b + col);
            f32x4 r; r.x = acc[4 * q] * rstd * w4.x + b4.x; r.y = acc[4 * q + 1] * rstd * w4.y + b4.y; r.z = acc[4 * q + 2] * rstd * w4.z + b4.z; r.w = acc[4 * q + 3] * rstd * w4.w + b4.w;
            *(f32x4*)(F.out + (size_t)row * D + col) = r;
        }
    }
}

constexpr int CW_BAR = 4096;
constexpr int LDS_BARST_OFF = LDS_BYTES - 64;
#define XB_TMO      128
#define XB_XCNT(j)  (256  + 64 * (j))
#define XB_XSUB(j)  (1280 + 64 * (j))
#define XB_XGEN(j)  (2304 + 64 * (j))
#define XB_TOP      3328
#define XB_TOPGEN   3392
#define XCD_BAR_WORDS 3456
#define XB_SPIN_CAP (1u << 18)

__device__ __forceinline__ unsigned xb_ld(unsigned* p)              { return __hip_atomic_load(p, __ATOMIC_RELAXED, __HIP_MEMORY_SCOPE_AGENT); }
__device__ __forceinline__ unsigned xb_add(unsigned* p, unsigned v) { return __hip_atomic_fetch_add(p, v, __ATOMIC_RELAXED, __HIP_MEMORY_SCOPE_AGENT); }
__device__ __forceinline__ unsigned xb_xcc_id() { return (unsigned)__builtin_amdgcn_s_getreg((3 << 11) | 20) & 0xFu; }
#define XB_SPIN(cond, bar) do { unsigned _sp = 0; while (cond) { __builtin_amdgcn_s_sleep(1); \
    if ((++_sp & 255u) == 0u) { if (xb_ld(&(bar)[XB_TMO])) break; if (_sp > XB_SPIN_CAP) { atomicAdd(&(bar)[XB_TMO], 1u); break; } } } } while (0)

struct XcdBarrier {
    unsigned* bar; unsigned x;
    volatile LAS unsigned* st;
};

__device__ __forceinline__ XcdBarrier xcd_barrier_post(unsigned* bar, volatile LAS unsigned* st) {
    XcdBarrier b; b.bar = bar; b.x = xb_xcc_id(); b.st = st;
    if (threadIdx.x == 0) (void)xb_add(&bar[XB_XCNT(b.x)], 1u);
    return b;
}
__device__ __forceinline__ void xcd_barrier_complete(unsigned* bar, unsigned x, unsigned& nloc, unsigned& nx) {
    const unsigned G = gridDim.x * gridDim.y * gridDim.z;
    unsigned sum, cnt, mine, sp = 0u;
    for (;;) {
        sum = 0u; cnt = 0u; mine = 0u;
#pragma unroll
        for (unsigned j = 0; j < 16; ++j) { const unsigned c = xb_ld(&bar[XB_XCNT(j)]); sum += c; cnt += (c > 0u) ? 1u : 0u; mine = (j == x) ? c : mine; }
        if (sum == G) break;
        __builtin_amdgcn_s_sleep(1);
        if ((++sp & 255u) == 0u) { if (xb_ld(&bar[XB_TMO])) break; if (sp > XB_SPIN_CAP) { atomicAdd(&bar[XB_TMO], 1u); break; } }
    }
    nloc = mine > 0u ? mine : 1u; nx = cnt > 0u ? cnt : 1u;
}

__device__ __forceinline__ void xcd_barrier(const XcdBarrier& b) {
    asm volatile("s_waitcnt vmcnt(0)" ::: "memory");
    __syncthreads();
    if (threadIdx.x == 0) {
        unsigned* bar = b.bar;
        __builtin_amdgcn_s_waitcnt(0);
        unsigned nloc = b.st[0], nx = b.st[1];
        if (nloc == 0u) { xcd_barrier_complete(bar, b.x, nloc, nx); b.st[0] = nloc; b.st[1] = nx; }
        const unsigned old = xb_add(&bar[XB_XSUB(b.x)], 1u);
        const unsigned gen = old / nloc;
        if (old + 1u == (gen + 1u) * nloc) {
            __builtin_amdgcn_fence(__ATOMIC_RELEASE, "agent");
            asm volatile("s_waitcnt vmcnt(0)" ::: "memory");
            const unsigned og = xb_add(&bar[XB_TOP], 1u);
            const unsigned tg = og / nx;
            if (og + 1u == (tg + 1u) * nx) xb_add(&bar[XB_TOPGEN], 1u);
            else XB_SPIN(xb_ld(&bar[XB_TOPGEN]) == tg, bar);
            __builtin_amdgcn_fence(__ATOMIC_ACQUIRE, "agent");
            xb_add(&bar[XB_XGEN(b.x)], 1u);
            asm volatile("s_waitcnt vmcnt(0)" ::: "memory");
        } else {
            XB_SPIN(xb_ld(&bar[XB_XGEN(b.x)]) == gen, bar);
            __builtin_amdgcn_fence(__ATOMIC_ACQUIRE, "agent");
            asm volatile("s_waitcnt vmcnt(0)" ::: "memory");
        }
    }
    __syncthreads();
}

__global__ void __launch_bounds__(NTHREADS, 2) mega_fwd(Args args) {
    extern __shared__ __attribute__((aligned(16))) unsigned char lds[];
    Frame F;
    F.lds = (LAS unsigned char*)lds;
    F.wave = __builtin_amdgcn_readfirstlane((int)threadIdx.x >> 6);
    F.G = gridDim.x; { const int bx = blockIdx.x; F.vcu = (F.G % 8 == 0) ? (bx % 8) * (F.G / 8) + bx / 8 : bx; }
    F.out = args.out; F.ws = args.ws;
    const int lo = args.ph_lo, hi = args.ph_hi;
    if (threadIdx.x < 16) ((LAS unsigned*)(F.lds + LDS_BARST_OFF))[threadIdx.x] = 0u;
    __syncthreads();
    XcdBarrier bar = xcd_barrier_post((unsigned*)(F.ws + WS_CTL) + CW_BAR, (volatile LAS unsigned*)(F.lds + LDS_BARST_OFF));
#ifndef PHMASK
#define PHMASK 0x1ff
#endif
#define IN(k) (((PHMASK >> (k)) & 1) && lo <= (k) && (k) < hi)
#ifndef PHREP
#define PHREP 0
#endif
#define REP(k) (1 + ((PHREP >> (k)) & 1))
#ifndef CG_SEAM0
#define CG_SEAM0 0
#endif
#define SEAM(k) do { if (IN(k) && IN((k) + 1)) { if (CG_SEAM0 && (k) == 0) { asm volatile("s_waitcnt vmcnt(0)" ::: "memory"); __syncthreads(); cg::this_grid().sync(); } \
    xcd_barrier(bar); } } while (0)

    for (int rep_ = 0; rep_ < REP(0); ++rep_) { if (rep_) xcd_barrier(bar);

#if 1
    xcd_barrier(bar);
#endif
    if (IN(0)) { p0_prologue(F, kin(0), kin(1), kin(2), kin(3), kin(4), kin(11), kin(12), kin(13), kin(14), kin(17)); } } SEAM(0);
    for (int rep_ = 0; rep_ < REP(1); ++rep_) { if (rep_) xcd_barrier(bar);
    if (IN(1)) {
        pg8::Gemm g{(const pg8::bf16_t*)(F.ws + WS_XN), (const pg8::bf16_t*)(F.ws + WS_W1T), M, PROJ_LD, D};
        Sched1 S; S.init(F.G, (int)blockIdx.x);
        Epi1 E{(bf16*)(F.ws + WS_PROJ), (float*)(F.ws + WS_AB), (bf16*)(F.ws + WS_MKV), kin(8)};
        pg8::gemm_phase<Epi1, Sched1, true, true>(F.lds, g, S, E, F.wave, fresh_lane());
    } } SEAM(1);
    for (int rep_ = 0; rep_ < REP(2); ++rep_) { if (rep_) xcd_barrier(bar);
    if (IN(2)) { for (int pair = F.vcu; pair < BATCH * GH * 32; pair += F.G) gdn_prep_pair(F, pair, kin(5), kin(6), kin(7)); } } SEAM(2);
    for (int rep_ = 0; rep_ < REP(3); ++rep_) { if (rep_) xcd_barrier(bar);
    if (IN(3)) {
#ifndef NO_GDN
#ifndef REP_SCAN
#define REP_SCAN 1
#endif
#ifndef REP_SBMEM
#define REP_SBMEM 1
#endif
        if (blockIdx.x < BATCH * GH) { for (int rs_ = 0; rs_ < REP_SCAN; ++rs_) gdn_scan_unit(F, (int)blockIdx.x, kin(8)); }
#else
        if (0) {}
#endif
        else {
            const int g2 = (int)blockIdx.x - BATCH * GH, NG2 = F.G - BATCH * GH;
            unsigned* kvflag = (unsigned*)(F.ws + WS_CTL) + CW_KVFLAG;
            const bool kvwg = NG2 >= 64 && g2 >= 32 && g2 < 48;
            if (NG2 < 64 ? (g2 == 0) : kvwg) {
                for (int e = (NG2 < 64 ? 0 : g2 - 32); e < 16; e += (NG2 < 64 ? 1 : 16)) {
                    pg8::Gemm g{(const pg8::bf16_t*)(F.ws + WS_XN), (const pg8::bf16_t*)(F.ws + WS_W1T), M, N1, D};
                    SchedKV S{e}; Epi1 E{(bf16*)(F.ws + WS_PROJ), (float*)(F.ws + WS_AB), (bf16*)(F.ws + WS_MKV), kin(8)};
                    pg8::gemm_phase<Epi1, SchedKV, true, true>(F.lds, g, S, E, F.wave, fresh_lane());
                }
                asm volatile("s_waitcnt vmcnt(0)" ::: "memory");
                __syncthreads();
                if (threadIdx.x == 0) { __builtin_amdgcn_fence(__ATOMIC_RELEASE, "agent"); __hip_atomic_fetch_add(kvflag, (NG2 < 64 ? 16u : 1u), __ATOMIC_RELAXED, __HIP_MEMORY_SCOPE_AGENT); }
            }
#ifndef NO_SB
            for (int unit = g2; unit < 256; unit += NG2) sb_unit(F, unit, kin(9));
#endif
            {
                __syncthreads();
                const int lane_t = fresh_lane(); LAS float* scr = (LAS float*)(F.lds + F.wave * 16384);
                constexpr int I_O = (D / 64) * (D / 32);
                for (int it = g2 * NWAVES + F.wave; it < 2 * I_O; it += NG2 * NWAVES) {
                    if (it < I_O) transpose_item<false>(kin(14), D, D, (bf16*)(F.ws + WS_WOT), 0, scr, it, lane_t);
                    else transpose_item<false>(kin(17), D, D, (bf16*)(F.ws + WS_WQT), 0, scr, it - I_O, lane_t);
                }
                {
                    const int gt = NG2 >= 64 ? (g2 >= 48 ? g2 - 48 : -1) : g2, ngt = NG2 >= 64 ? NG2 - 48 : NG2;
                    peer_tables_convert(F, kin(20), kin(21), gt < 0 ? 2 * PE_NEXP : gt * NWAVES + F.wave, ngt * NWAVES, g2 * NWAVES + F.wave);
                }
            }
            if (threadIdx.x == 0) { unsigned sp_ = 0; while (__hip_atomic_load(kvflag, __ATOMIC_RELAXED, __HIP_MEMORY_SCOPE_AGENT) < 16u) { __builtin_amdgcn_s_sleep(2); if (++sp_ > (1u << 22)) break; } }
            __syncthreads();
#ifndef NO_MEM
            for (int unit = 255 - g2; unit >= 0; unit -= NG2) mem_unit(F, unit, kin(10));
#endif
        }
    } } SEAM(3);
    for (int rep_ = 0; rep_ < REP(4); ++rep_) { if (rep_) xcd_barrier(bar);
    if (IN(4)) {
        pg8::Gemm g{(const pg8::bf16_t*)(F.ws + WS_OMIX), (const pg8::bf16_t*)(F.ws + WS_WOT), M, D, D};
        pg8::StaticOrder S; S.init(M, D, F.G, (int)blockIdx.x);
        Epi2 E{(const bf16*)(F.ws + WS_XN), (bf16*)(F.ws + WS_Y1)};
        pg8::gemm_phase<Epi2, pg8::StaticOrder, true, true>(F.lds, g, S, E, F.wave, fresh_lane());
    } } SEAM(4);
    for (int rep_ = 0; rep_ < REP(5); ++rep_) { if (rep_) xcd_barrier(bar);
    if (IN(5)) { p5_ln1_tables(F, kin(15), kin(16), kin(20), kin(21)); } } SEAM(5);
    for (int rep_ = 0; rep_ < REP(6); ++rep_) { if (rep_) xcd_barrier(bar);
    if (IN(6)) {
        pg8::Gemm g{(const pg8::bf16_t*)(F.ws + WS_XN), (const pg8::bf16_t*)(F.ws + WS_WQT), M, D, D};
        pg8::StaticOrder S; S.init(M, D, F.G, (int)blockIdx.x);
        Epi3 E{(bf16*)(F.ws + WS_Q)};
        pg8::gemm_phase<Epi3, pg8::StaticOrder, true, true>(F.lds, g, S, E, F.wave, fresh_lane());
    } } SEAM(6);
    for (int rep_ = 0; rep_ < REP(7); ++rep_) { if (rep_) xcd_barrier(bar);
    if (IN(7)) { p7_peer_scores(F, kin(18), kin(19)); } } SEAM(7);
    for (int rep_ = 0; rep_ < REP(8); ++rep_) { if (rep_) xcd_barrier(bar);
#ifndef REP_P8A
#define REP_P8A 1
#endif
#ifndef REP_P8B
#define REP_P8B 1
#endif
    if (IN(8)) { for (int r8_ = 0; r8_ < REP_P8A; ++r8_) p8a_peer_u(F); xcd_barrier(bar); for (int r8_ = 0; r8_ < REP_P8B; ++r8_) p8_peer_experts(F, kin(22), kin(23)); } }
#undef IN
#undef SEAM
}

extern "C" void kernel_launch(void* const* d_in, const int* in_sizes, int n_in, void* d_out, int out_size, void* d_ws, size_t ws_size, hipStream_t stream) {
    static int grid = 0;
    if (grid == 0) {
        if (n_in != 24 || out_size != M * D || ws_size < WS_END) { fprintf(stderr, "kernel_launch: unexpected problem: n_in %d out %d ws %zu\n", n_in, out_size, ws_size); grid = -1; return; }
        int dev = 0, cus = 0, per_cu = 0;
        if (hipGetDevice(&dev) != hipSuccess || hipDeviceGetAttribute(&cus, hipDeviceAttributeMultiprocessorCount, dev) != hipSuccess) { grid = -1; return; }
        if (hipFuncSetAttribute((const void*)mega_fwd, hipFuncAttributeMaxDynamicSharedMemorySize, LDS_BYTES) != hipSuccess) { fprintf(stderr, "kernel_launch: hipFuncSetAttribute failed\n"); grid = -1; return; }
        if (hipOccupancyMaxActiveBlocksPerMultiprocessor(&per_cu, (const void*)mega_fwd, NTHREADS, LDS_BYTES) != hipSuccess || per_cu < 1) { fprintf(stderr, "kernel_launch: occupancy query says %d\n", per_cu); per_cu = 1; }
        (void)hipGetLastError();
        grid = cus * (per_cu >= 1 ? 1 : 0);
        fprintf(stderr, "kernel_launch: grid %d (cus %d, occupancy/CU %d), ws %zu\n", grid, cus, per_cu, ws_size);
    }
    if (grid <= 0) return;
    (void)hipMemsetAsync((char*)d_ws + WS_CTL, 0, CTL_ZERO_BYTES, stream);
    Args a{};
    for (int i = 0; i < 24; ++i) a.in[i] = (const float*)d_in[i];
    a.out = (float*)d_out; a.ws = (unsigned char*)d_ws;
#if MK_N_LAUNCHES == 1
    a.ph_lo = 0; a.ph_hi = NPHASES;
    void* kargs[] = {&a};
    hipError_t e = hipLaunchCooperativeKernel((const void*)mega_fwd, dim3(grid), dim3(NTHREADS), kargs, LDS_BYTES, stream);
    if (e != hipSuccess) fprintf(stderr, "kernel_launch: cooperative launch failed: %s\n", hipGetErrorString(e));
#else
    for (int p = 0; p < NPHASES; ++p) { a.ph_lo = p; a.ph_hi = p + 1; hipLaunchKernelGGL(mega_fwd, dim3(grid), dim3(NTHREADS), LDS_BYTES, stream, a); }
#endif
}
```
